# Optimizing an MI355X kernel written in HIP

```python
import jax, jax.numpy as jnp
from jax import lax
import numpy as np

D_MODEL = 1024
BATCH = 2
SEQ = 8192
DEPTH = 1

HEAD_DIM = 64
GRID_W = 64
NA_HEADS = 8
NA_KH = 8
NA_KW = 16
DIL_CONFIGS = ((128, 1), (512, 4), (2048, 16))
DIL_HEADS_PER_GROUP = 4
DIL_HEADS = DIL_HEADS_PER_GROUP * len(DIL_CONFIGS)
DIL_QBLOCK = 64
ROT_DIM = HEAD_DIM // 4
ROPE_THETA = 500000.0
D_FF = -(-8 * D_MODEL // (3 * 256)) * 256
EPS = 1e-6
NEG_INF = -1e30
WA = NA_HEADS * HEAD_DIM
WB = DIL_HEADS * HEAD_DIM
WB_OUT = DIL_HEADS_PER_GROUP * HEAD_DIM
W_IN = 3 * WA + 3 * WB + 2 * D_MODEL

kernel_name = "hybrid_natten_dilated_gated_encoder"

f32 = jnp.float32


def rms_norm(x, g):
    x32 = x.astype(f32)
    y = x32 * lax.rsqrt(jnp.mean(x32 * x32, axis=-1, keepdims=True) + EPS)
    return (y * g.astype(f32)).astype(x.dtype)


def partial_rotary(t, pos):
    half = ROT_DIM // 2
    inv_freq = ROPE_THETA ** (-(jnp.arange(half, dtype=f32) * 2.0) / ROT_DIM)
    ang = pos.astype(f32)[:, None] * inv_freq[None, :]
    cos = jnp.cos(ang)[None, :, None, :]
    sin = jnp.sin(ang)[None, :, None, :]
    x1 = t[..., :half].astype(f32)
    x2 = t[..., half:ROT_DIM].astype(f32)
    rot = jnp.concatenate([x1 * cos - x2 * sin, x2 * cos + x1 * sin], axis=-1).astype(t.dtype)
    return jnp.concatenate([rot, t[..., ROT_DIM:]], axis=-1)


def neighbourhood_attention(q, k, v, rpb):
    b, s, h, dh = q.shape
    rows = s // GRID_W
    kh = min(NA_KH, rows)
    qg = q.reshape(b, rows, GRID_W, h, dh)
    kg = k.reshape(b, rows, GRID_W, h, dh)
    vg = v.reshape(b, rows, GRID_W, h, dh)
    r = jnp.arange(rows)
    row_start = jnp.clip(r - kh // 2, 0, rows - kh)
    row_idx = row_start[:, None] + jnp.arange(kh)[None, :]
    kn = kg[:, row_idx].reshape(b, rows, kh * GRID_W, h, dh)
    vn = vg[:, row_idx].reshape(b, rows, kh * GRID_W, h, dh)
    col = jnp.arange(GRID_W)
    col_start = jnp.clip(col - NA_KW // 2, 0, GRID_W - NA_KW)
    col_mask = (col[None, :] >= col_start[:, None]) & (col[None, :] < col_start[:, None] + NA_KW)
    mask = jnp.broadcast_to(col_mask[:, None, :], (GRID_W, kh, GRID_W)).reshape(GRID_W, kh * GRID_W)
    row_off = row_idx - r[:, None] + (NA_KH - 1)
    col_off = jnp.clip(col[None, :] - col[:, None] + (NA_KW - 1), 0, 2 * NA_KW - 2)
    bias = rpb[:, row_off[:, None, :, None], col_off[None, :, None, :]]
    bias = bias.reshape(h, rows, GRID_W, kh * GRID_W).astype(f32)
    scores = jnp.einsum('brqhd,brkhd->bhrqk', qg, kn).astype(f32) * (dh ** -0.5) + bias[None]
    scores = jnp.where(mask, scores, NEG_INF)
    p = jax.nn.softmax(scores, axis=-1).astype(v.dtype)
    o = jnp.einsum('bhrqk,brkhd->brqhd', p, vn)
    return o.reshape(b, s, h * dh)


def dilated_window_attention(q, k, v, window, dilation):
    b, s, h, dh = q.shape
    half = (window // 2) // dilation
    seg = s // dilation

    def split(t):
        return t.reshape(b, seg, dilation, h, dh).transpose(0, 2, 1, 3, 4).reshape(b * dilation, seg, h, dh)

    qs, ks, vs = split(q), split(k), split(v)
    nb = -(-seg // DIL_QBLOCK)
    lp = nb * DIL_QBLOCK
    qs = jnp.pad(qs, ((0, 0), (0, lp - seg), (0, 0), (0, 0)))
    pad_k = ((0, 0), (half, lp - seg + half), (0, 0), (0, 0))
    kp, vp = jnp.pad(ks, pad_k), jnp.pad(vs, pad_k)
    span = DIL_QBLOCK + 2 * half
    key_idx = jnp.arange(nb)[:, None] * DIL_QBLOCK + jnp.arange(span)[None, :]
    kb = kp[:, key_idx]
    vb = vp[:, key_idx]
    qb = qs.reshape(-1, nb, DIL_QBLOCK, h, dh)
    qpos = jnp.arange(nb)[:, None] * DIL_QBLOCK + jnp.arange(DIL_QBLOCK)[None, :]
    kpos = key_idx - half
    rel = kpos[:, None, :] - qpos[:, :, None]
    mask = (jnp.abs(rel) <= half) & (kpos[:, None, :] >= 0) & (kpos[:, None, :] < seg)
    scores = jnp.einsum('nbqhd,nbkhd->nhbqk', qb, kb).astype(f32) * (dh ** -0.5)
    scores = jnp.where(mask[None, None], scores, NEG_INF)
    lse = jax.nn.logsumexp(scores, axis=-1)
    p = jnp.exp(scores - lse[..., None]).astype(v.dtype)
    o = jnp.einsum('nhbqk,nbkhd->nbqhd', p, vb).reshape(-1, lp, h, dh)[:, :seg]
    lse = lse.transpose(0, 2, 3, 1).reshape(-1, lp, h)[:, :seg]
    o = o.reshape(b, dilation, seg, h, dh).transpose(0, 2, 1, 3, 4).reshape(b, s, h, dh)
    lse = lse.reshape(b, dilation, seg, h).transpose(0, 2, 1, 3).reshape(b, s, h)
    return o, lse


def setup_inputs(seed: int = 0) -> dict:
    key = jax.random.key(seed)
    ks = jax.random.split(key, 20)
    nrm = lambda k, shape, scale: jax.random.normal(k, shape, f32) * scale
    d = D_MODEL
    return {
        "x": nrm(ks[0], (BATCH, SEQ, d), 1.0),
        "c": nrm(ks[1], (BATCH, d), 1.0),
        "w_ada": nrm(ks[2], (DEPTH, d, 6 * d), 0.5 * d ** -0.5),
        "b_ada": nrm(ks[3], (DEPTH, 6 * d), 0.02),
        "g_norm1": 1.0 + nrm(ks[4], (DEPTH, d), 0.05),
        "g_norm2": 1.0 + nrm(ks[5], (DEPTH, d), 0.05),
        "w_in": nrm(ks[6], (DEPTH, d, W_IN), d ** -0.5),
        "b_gate": nrm(ks[7], (DEPTH, 2 * d), 0.02),
        "g_qa": 1.0 + nrm(ks[8], (DEPTH, HEAD_DIM), 0.05),
        "g_ka": 1.0 + nrm(ks[9], (DEPTH, HEAD_DIM), 0.05),
        "g_qb": 1.0 + nrm(ks[10], (DEPTH, HEAD_DIM), 0.05),
        "g_kb": 1.0 + nrm(ks[11], (DEPTH, HEAD_DIM), 0.05),
        "rpb": nrm(ks[12], (DEPTH, NA_HEADS, 2 * NA_KH - 1, 2 * NA_KW - 1), 0.1),
        "w_proj_a": nrm(ks[13], (DEPTH, WA, d), WA ** -0.5),
        "w_proj_b": nrm(ks[14], (DEPTH, WB_OUT, d), WB_OUT ** -0.5),
        "w_o": nrm(ks[15], (DEPTH, d, d), d ** -0.5),
        "w_ffn_in": nrm(ks[16], (DEPTH, d, 2 * D_FF), d ** -0.5),
        "w_ffn_out": nrm(ks[17], (DEPTH, D_FF, d), D_FF ** -0.5),
    }


def reference(x, c, w_ada, b_ada, g_norm1, g_norm2, w_in, b_gate, g_qa, g_ka, g_qb, g_kb,
              rpb, w_proj_a, w_proj_b, w_o, w_ffn_in, w_ffn_out):
    b, s, _ = x.shape
    pos = jnp.arange(s)
    c_act = jax.nn.silu(c)
    split_at = [WA, 2 * WA, 3 * WA, 3 * WA + WB, 3 * WA + 2 * WB, 3 * WA + 3 * WB]
    for l in range(DEPTH):
        mod = c_act @ w_ada[l] + b_ada[l]
        sh1, sc1, gt1, sh2, sc2, gt2 = [m[:, None, :] for m in jnp.split(mod, 6, axis=-1)]

        h = rms_norm(x, g_norm1[l]) * (1.0 + sc1) + sh1
        proj = h @ w_in[l]
        qa, ka, va, qb, kb, vb, gates = jnp.split(proj, split_at, axis=-1)

        qa = rms_norm(qa.reshape(b, s, NA_HEADS, HEAD_DIM), g_qa[l])
        ka = rms_norm(ka.reshape(b, s, NA_HEADS, HEAD_DIM), g_ka[l])
        va = va.reshape(b, s, NA_HEADS, HEAD_DIM)
        o_a = neighbourhood_attention(qa, ka, va, rpb[l])

        qb = partial_rotary(rms_norm(qb.reshape(b, s, DIL_HEADS, HEAD_DIM), g_qb[l]), pos)
        kb = partial_rotary(rms_norm(kb.reshape(b, s, DIL_HEADS, HEAD_DIM), g_kb[l]), pos)
        vb = vb.reshape(b, s, DIL_HEADS, HEAD_DIM)
        outs, lses = [], []
        for g, (win, dil) in enumerate(DIL_CONFIGS):
            sl = slice(g * DIL_HEADS_PER_GROUP, (g + 1) * DIL_HEADS_PER_GROUP)
            o_g, lse_g = dilated_window_attention(qb[:, :, sl], kb[:, :, sl], vb[:, :, sl], win, dil)
            outs.append(o_g)
            lses.append(lse_g)
        wts = jax.nn.softmax(jnp.stack(lses, axis=0), axis=0)
        o_b = jnp.einsum('gbsh,gbshd->bshd', wts.astype(vb.dtype), jnp.stack(outs, axis=0))
        o_b = o_b.reshape(b, s, WB_OUT)

        gate_a, gate_b = jnp.split(jax.nn.sigmoid(gates + b_gate[l]), 2, axis=-1)
        merged = gate_a * (o_a @ w_proj_a[l]) + gate_b * (o_b @ w_proj_b[l])
        x = x + gt1 * (merged @ w_o[l])

        h2 = rms_norm(x, g_norm2[l]) * (1.0 + sc2) + sh2
        a, up = jnp.split(h2 @ w_ffn_in[l], 2, axis=-1)
        x = x + gt2 * ((jax.nn.silu(a) * up) @ w_ffn_out[l])
    return x
```

```cpp
#include <hip/hip_runtime.h>
#include <hip/hip_cooperative_groups.h>
#include <cstdio>
#include <cstdint>
namespace pg8 {
#define PG8_LAS __attribute__((address_space(3)))
typedef unsigned short bf16_t;
typedef short bf16x8 __attribute__((ext_vector_type(8)));
typedef float f32x4 __attribute__((ext_vector_type(4)));
typedef unsigned u32x4 __attribute__((ext_vector_type(4)));
constexpr int BM = 256, BK = 64, HALF = 128, HTB = HALF * BK * 2  , STAGE_BYTES = 8 * HTB, NXCD = 8, WGM = 8;

__host__ __device__ __forceinline__ int lds_byte(int r, int c) { const int st = (r >> 4) * 2 + (c >> 5), rr = r & 15, cc = c & 31, ob = rr * 64 + cc * 2; return st * 1024 + (ob ^ (((ob >> 9) & 1) << 5)); }
__host__ __device__ __forceinline__ void stage_rc(int b, int& R, int& C) { const int st = b / 1024, sb = b % 1024, swz = sb ^ (((sb >> 9) & 1) << 5); R = (st >> 1) * 16 + swz / 64; C = (st & 1) * 32 + (swz % 64) / 2; }
__host__ __device__ __forceinline__ int perm32(int rho) { const int n = rho >> 4, i = rho & 15; return 8 * (i >> 2) + 4 * n + (i & 3); }

struct Unit { int pm, pn; };
struct Gemm { const bf16_t* A; const bf16_t* Bt; int M, N, K; };

struct StaticOrder {
    int nM, nN, nwg, G, c;
    __host__ __device__ void init(int M, int N, int G_, int c_) { nM = M / BM; nN = N / BM; nwg = nM * nN; G = G_; c = c_; }
    __host__ __device__ bool next(int i, Unit& u) const {
        const long L = (long)i * G + c; if (L >= nwg) return false;
        int wgid = (int)L; { const int q = nwg / NXCD, r = nwg % NXCD, xcd = wgid % NXCD, off = wgid / NXCD; wgid = (xcd < r ? xcd * (q + 1) : r * (q + 1) + (xcd - r) * q) + off; }
        const int nig = WGM * nN, gid = wgid / nig, fm = gid * WGM, gsz = (nM - fm) < WGM ? (nM - fm) : WGM;
        u.pm = fm + ((wgid % nig) % gsz); u.pn = (wgid % nig) / gsz; return true;
    }
    __device__ __forceinline__ void a_ready(const Unit&) const {}
    __device__ __forceinline__ void done(const Unit&) const {}
};

__device__ __forceinline__ unsigned cvt_pk_bf16(float lo, float hi) { unsigned r; asm volatile("v_cvt_pk_bf16_f32 %0, %1, %2" : "=v"(r) : "v"(lo), "v"(hi)); return r; }
typedef float f32x2 __attribute__((ext_vector_type(2)));
__device__ __forceinline__ u32x4 pack8(const f32x4 a, const f32x4 b) { u32x4 w; w.x = cvt_pk_bf16(a[0], a[1]); w.y = cvt_pk_bf16(a[2], a[3]); w.z = cvt_pk_bf16(b[0], b[1]); w.w = cvt_pk_bf16(b[2], b[3]); return w; }
__device__ __forceinline__ float bf_lo(unsigned w) { return __uint_as_float(w << 16); }
__device__ __forceinline__ float bf_hi(unsigned w) { return __uint_as_float(w & 0xffff0000u); }

struct EpiIn {
    static constexpr bool PERM = true, AFTER_DRAIN = false;
    bf16_t *QA, *KA, *VA, *QB, *KB, *VB, *G;
    const float *g_qa, *g_ka, *g_qb, *g_kb, *b_gate, *rope;
    __device__ __forceinline__ void operator()(const f32x4 (&acc)[2][2][4][2], const Unit& u, int wr, int wc, int fr, int fq) const {
        asm volatile("" : "+v"(fr), "+v"(fq));
        const int pn = u.pn;
        bf16_t* base; int ldc, ct0, kind; const float* gw = g_qa; float qs = 1.0f;
        if (pn < 2)       { base = QA; ldc = 512;  ct0 = pn * 256;        kind = 1; gw = g_qa; qs = 0.125f; }
        else if (pn < 4)  { base = KA; ldc = 512;  ct0 = (pn - 2) * 256;  kind = 1; gw = g_ka; }
        else if (pn < 6)  { base = VA; ldc = 512;  ct0 = (pn - 4) * 256;  kind = 0; }
        else if (pn < 9)  { base = QB; ldc = 768;  ct0 = (pn - 6) * 256;  kind = 2; gw = g_qb; qs = 0.125f; }
        else if (pn < 12) { base = KB; ldc = 768;  ct0 = (pn - 9) * 256;  kind = 2; gw = g_kb; }
        else if (pn < 15) { base = VB; ldc = 768;  ct0 = (pn - 12) * 256; kind = 0; }
        else              { base = G;  ldc = 2048; ct0 = (pn - 15) * 256; kind = 3; }
        const int cw = ct0 + 64 * wc + 8 * fq;
        f32x4 wv[2][2];
#pragma unroll
        for (int bj = 0; bj < 2; ++bj)
#pragma unroll
            for (int n = 0; n < 2; ++n) {
                if (kind == 3) wv[bj][n] = *(const f32x4*)(b_gate + cw + 32 * bj + 4 * n);
                else wv[bj][n] = *(const f32x4*)(gw + 32 * bj + 8 * fq + 4 * n) * qs;
            }
#pragma unroll
        for (int ai = 0; ai < 2; ++ai)
#pragma unroll
            for (int m = 0; m < 4; ++m) {
                const int row = u.pm * BM + ai * HALF + wr * 64 + m * 16 + fr;
                f32x4 v[2][2];
#pragma unroll
                for (int bj = 0; bj < 2; ++bj)
#pragma unroll
                    for (int n = 0; n < 2; ++n) v[bj][n] = acc[ai][bj][m][n];
                if (kind == 1 || kind == 2) {
                    float ss = 0.f;
#pragma unroll
                    for (int bj = 0; bj < 2; ++bj)
#pragma unroll
                        for (int n = 0; n < 2; ++n) { const f32x4 x = v[bj][n]; ss += (x[0] * x[0] + x[1] * x[1]) + (x[2] * x[2] + x[3] * x[3]); }
                    ss += __shfl_xor(ss, 16); ss += __shfl_xor(ss, 32);
                    const float rstd = __builtin_amdgcn_rsqf(ss * (1.0f / 64.0f) + 1e-6f);
#pragma unroll
                    for (int bj = 0; bj < 2; ++bj)
#pragma unroll
                        for (int n = 0; n < 2; ++n) v[bj][n] = v[bj][n] * rstd * wv[bj][n];
                    if (kind == 2) {
                        const float* rp = rope + (size_t)(row & 8191) * 16;
                        const f32x4 c0 = *(const f32x4*)(rp), c1 = *(const f32x4*)(rp + 4), s0 = *(const f32x4*)(rp + 8), s1 = *(const f32x4*)(rp + 12);
                        f32x4 p0, p1;
#pragma unroll
                        for (int e = 0; e < 4; ++e) { p0[e] = __shfl_xor(v[0][0][e], 16); p1[e] = __shfl_xor(v[0][1][e], 16); }
                        if (fq == 0)      { v[0][0] = v[0][0] * c0 - p0 * s0; v[0][1] = v[0][1] * c1 - p1 * s1; }
                        else if (fq == 1) { v[0][0] = v[0][0] * c0 + p0 * s0; v[0][1] = v[0][1] * c1 + p1 * s1; }
                    }
                } else if (kind == 3) {
#pragma unroll
                    for (int bj = 0; bj < 2; ++bj)
#pragma unroll
                        for (int n = 0; n < 2; ++n)
#pragma unroll
                            for (int e = 0; e < 4; ++e) { const float x = v[bj][n][e] + wv[bj][n][e]; v[bj][n][e] = __builtin_amdgcn_rcpf(1.0f + __expf(-x)); }
                }
                bf16_t* rowp = base + (size_t)row * ldc + cw;
#pragma unroll
                for (int bj = 0; bj < 2; ++bj) *(u32x4*)(rowp + 32 * bj) = pack8(v[bj][0], v[bj][1]);
            }
    }
};

struct EpiGateA {
    static constexpr bool PERM = true, AFTER_DRAIN = false;
    const bf16_t* G; int ldg; float* T;
    __device__ __forceinline__ void operator()(const f32x4 (&acc)[2][2][4][2], const Unit& u, int wr, int wc, int fr, int fq) const {
        asm volatile("" : "+v"(fr), "+v"(fq));
        const int col0 = u.pn * BM + wc * 32 + 8 * fq;
#pragma unroll
        for (int ai = 0; ai < 2; ++ai)
#pragma unroll
            for (int m = 0; m < 4; ++m) { const size_t row = (size_t)(u.pm * BM + ai * HALF + wr * 64 + m * 16 + fr);
#pragma unroll
                for (int bj = 0; bj < 2; ++bj) { const u32x4 g = *(const u32x4*)(G + row * ldg + col0 + bj * HALF);
                    f32x4 a = acc[ai][bj][m][0], b = acc[ai][bj][m][1];
                    a[0] *= bf_lo(g.x); a[1] *= bf_hi(g.x); a[2] *= bf_lo(g.y); a[3] *= bf_hi(g.y); b[0] *= bf_lo(g.z); b[1] *= bf_hi(g.z); b[2] *= bf_lo(g.w); b[3] *= bf_hi(g.w);
                    float* tp = T + row * 1024 + col0 + bj * HALF; *(f32x4*)tp = a; *(f32x4*)(tp + 4) = b; }
                asm volatile("" ::: "memory"); }
    }
};
struct EpiGateB {
    static constexpr bool PERM = true, AFTER_DRAIN = false;
    const bf16_t* G; int ldg; const float* T; bf16_t* O;
    __device__ __forceinline__ void operator()(const f32x4 (&acc)[2][2][4][2], const Unit& u, int wr, int wc, int fr, int fq) const {
        asm volatile("" : "+v"(fr), "+v"(fq));
        const int col0 = u.pn * BM + wc * 32 + 8 * fq;
#pragma unroll
        for (int ai = 0; ai < 2; ++ai)
#pragma unroll
            for (int m = 0; m < 4; ++m) { const size_t row = (size_t)(u.pm * BM + ai * HALF + wr * 64 + m * 16 + fr);
#pragma unroll
                for (int bj = 0; bj < 2; ++bj) { const u32x4 g = *(const u32x4*)(G + row * ldg + col0 + bj * HALF);
                    const float* tp = T + row * 1024 + col0 + bj * HALF; const f32x4 t0 = *(const f32x4*)tp, t1 = *(const f32x4*)(tp + 4);
                    f32x4 a = acc[ai][bj][m][0], b = acc[ai][bj][m][1];
                    a[0] = t0[0] + a[0] * bf_lo(g.x); a[1] = t0[1] + a[1] * bf_hi(g.x); a[2] = t0[2] + a[2] * bf_lo(g.y); a[3] = t0[3] + a[3] * bf_hi(g.y);
                    b[0] = t1[0] + b[0] * bf_lo(g.z); b[1] = t1[1] + b[1] * bf_hi(g.z); b[2] = t1[2] + b[2] * bf_lo(g.w); b[3] = t1[3] + b[3] * bf_hi(g.w);
                    *(u32x4*)(O + row * 1024 + col0 + bj * HALF) = pack8(a, b); asm volatile("" ::: "memory"); } }
    }
};
struct EpiRes {
    static constexpr bool PERM = false, AFTER_DRAIN = false;
    const float* base; float* out; const float* gt;
    __device__ __forceinline__ void operator()(const f32x4 (&acc)[2][2][4][2], const Unit& u, int wr, int wc, int fr, int fq) const {
        asm volatile("" : "+v"(fr), "+v"(fq));
        const int col0 = u.pn * BM + wc * 32 + 4 * fq; const float* gb = gt + (size_t)(u.pm >> 5) * 6144;
        f32x4 gv[2][2];
#pragma unroll
        for (int bj = 0; bj < 2; ++bj)
#pragma unroll
            for (int n = 0; n < 2; ++n) gv[bj][n] = *(const f32x4*)(gb + col0 + bj * HALF + n * 16);
#pragma unroll
        for (int ai = 0; ai < 2; ++ai)
#pragma unroll
            for (int m = 0; m < 4; ++m) { const size_t off = (size_t)(u.pm * BM + ai * HALF + wr * 64 + m * 16 + fr) * 1024 + col0;
#pragma unroll
                for (int bj = 0; bj < 2; ++bj)
#pragma unroll
                    for (int n = 0; n < 2; ++n) { const f32x4 bs = *(const f32x4*)(base + off + bj * HALF + n * 16); *(f32x4*)(out + off + bj * HALF + n * 16) = bs + gv[bj][n] * acc[ai][bj][m][n]; } }
    }
};
struct EpiSwiglu {
    static constexpr bool PERM = true, AFTER_DRAIN = false;
    bf16_t* O; int ldc;
    __device__ __forceinline__ void operator()(const f32x4 (&acc)[2][2][4][2], const Unit& u, int wr, int wc, int fr, int fq) const {
        asm volatile("" : "+v"(fr), "+v"(fq));
        const int col0 = u.pn * HALF + wc * 32 + 8 * fq;
#pragma unroll
        for (int ai = 0; ai < 2; ++ai)
#pragma unroll
            for (int m = 0; m < 4; ++m) { const size_t row = (size_t)(u.pm * BM + ai * HALF + wr * 64 + m * 16 + fr);
                f32x4 r[2];
#pragma unroll
                for (int n = 0; n < 2; ++n)
#pragma unroll
                    for (int e = 0; e < 4; ++e) { const float a = acc[ai][0][m][n][e], up = acc[ai][1][m][n][e]; r[n][e] = a * __builtin_amdgcn_rcpf(1.0f + __expf(-a)) * up; }
                *(u32x4*)(O + row * ldc + col0) = pack8(r[0], r[1]); }
    }
};
template <class Epi, class Sched, bool ALIGN_EPI = false, bool SP2 = false>
__device__ __forceinline__ void gemm_phase(PG8_LAS unsigned char* lds, const Gemm g, const Sched& S, const Epi& E) {
    int tid_ = threadIdx.x; asm volatile("" : "+v"(tid_));
    const int tid = tid_, wid = __builtin_amdgcn_readfirstlane(tid >> 6), lane = tid & 63, wr = wid >> 2, wc = wid & 3, fr = lane & 15, fq = lane >> 4;
    const int K = g.K, nt = K / BK;
    unsigned voffA[2], voffB[2];
#pragma unroll
    for (int i = 0; i < 2; ++i) { int R, C; stage_rc(tid * 16 + i * 8192, R, C); const int Rb = Epi::PERM ? ((R & ~31) + perm32(R & 31)) : R;
        voffA[i] = (unsigned)(R * K + C) * 2u; voffB[i] = (unsigned)(Rb * K + C) * 2u; }
    const size_t kstep = (size_t)(BK * 2);
    const size_t hstep = (size_t)HALF * K * 2;
    const size_t tstep = 2 * hstep;
    const unsigned ldsw = (unsigned)wid * 1024u;
    const int aoff = lds_byte(wr * 64 + fr, fq * 8), boff = lds_byte(wc * 32 + fr, fq * 8);
#define PG8_SA(b, h) (((b) * 2 + (h)) * HTB)
#define PG8_SB(b, h) ((4 + (b) * 2 + (h)) * HTB)
#define PG8_STAGE(bufoff, gbase, voff) do { _Pragma("unroll") for (int _i = 0; _i < 2; ++_i) \
        __builtin_amdgcn_global_load_lds((const unsigned*)((const char*)(gbase) + (voff)[_i]), (PG8_LAS unsigned*)(lds + (bufoff) + ldsw + _i * 8192), 16, 0, 0); } while (0)
#define PG8_LDA(dst, b, h) do { _Pragma("unroll") for (int m = 0; m < 4; ++m) _Pragma("unroll") for (int k = 0; k < 2; ++k) dst[m][k] = *(const PG8_LAS bf16x8*)(lds + PG8_SA(b, h) + aoff + m * 2048 + k * 1024); } while (0)
#define PG8_LDB(dst, b, h) do { _Pragma("unroll") for (int n = 0; n < 2; ++n) _Pragma("unroll") for (int k = 0; k < 2; ++k) dst[n][k] = *(const PG8_LAS bf16x8*)(lds + PG8_SB(b, h) + boff + n * 2048 + k * 1024); } while (0)
#define PG8_MMA(ai, bj, At, Bt) do { __builtin_amdgcn_s_setprio(1); _Pragma("unroll") for (int m = 0; m < 4; ++m) _Pragma("unroll") for (int n = 0; n < 2; ++n) _Pragma("unroll") for (int k = 0; k < 2; ++k) \
        acc[ai][bj][m][n] = __builtin_amdgcn_mfma_f32_16x16x32_bf16(Bt[n][k], At[m][k], acc[ai][bj][m][n], 0, 0, 0); __builtin_amdgcn_s_setprio(0); } while (0)
#define PG8_WAIT_V(n) asm volatile("s_waitcnt vmcnt(" #n ")" ::: "memory")
#define PG8_WAIT_L(n) asm volatile("s_waitcnt lgkmcnt(" #n ")" ::: "memory")
#define PG8_BAR __builtin_amdgcn_s_barrier()
#define PG8_SCHED __builtin_amdgcn_sched_barrier(0)
    Unit cur, nxt; int ui = 0;
    if (!S.next(0, cur)) return;
    f32x4 acc[2][2][4][2];
#pragma unroll
    for (int a = 0; a < 2; ++a)
#pragma unroll
        for (int b = 0; b < 2; ++b)
#pragma unroll
            for (int m = 0; m < 4; ++m)
#pragma unroll
                for (int n = 0; n < 2; ++n) acc[a][b][m][n] = (f32x4){0.f, 0.f, 0.f, 0.f};
    bf16x8 At[4][2], B0[2][2], B1[2][2];
    const char* cA = (const char*)g.A + (size_t)cur.pm * tstep; const char* cB = (const char*)g.Bt + (size_t)cur.pn * tstep;
    S.a_ready(cur);
    if constexpr (SP2) {
        PG8_STAGE(PG8_SB(0, 0), cB, voffB); PG8_STAGE(PG8_SB(0, 1), cB + hstep, voffB); PG8_STAGE(PG8_SA(0, 0), cA, voffA); PG8_STAGE(PG8_SA(0, 1), cA + hstep, voffA);
        if (wr == 1) PG8_BAR;
        PG8_WAIT_V(2); PG8_BAR;
        PG8_STAGE(PG8_SB(1, 0), cB + kstep, voffB); PG8_STAGE(PG8_SA(1, 0), cA + kstep, voffA); PG8_STAGE(PG8_SB(1, 1), cB + hstep + kstep, voffB);
        PG8_WAIT_V(6); PG8_BAR;
    } else {
        PG8_STAGE(PG8_SB(0, 0), cB, voffB); PG8_STAGE(PG8_SA(0, 0), cA, voffA); PG8_STAGE(PG8_SB(0, 1), cB + hstep, voffB); PG8_STAGE(PG8_SA(0, 1), cA + hstep, voffA);
        if (wr == 1) PG8_BAR;
        PG8_WAIT_V(4); PG8_BAR;
        PG8_STAGE(PG8_SB(1, 0), cB + kstep, voffB); PG8_STAGE(PG8_SA(1, 0), cA + kstep, voffA); PG8_STAGE(PG8_SB(1, 1), cB + hstep + kstep, voffB);
        PG8_WAIT_V(6); PG8_BAR;
    }
    for (;;) {
        const bool has_next = S.next(ui + 1, nxt);
        const char* nA = has_next ? (const char*)g.A + (size_t)nxt.pm * tstep : cA; const char* nB = has_next ? (const char*)g.Bt + (size_t)nxt.pn * tstep : cB;
        for (int t = 0; t < nt; t += 2) {
            const bool last = (t == nt - 2);
            const char* a1 = cA + (size_t)(t + 1) * kstep;
            const char* a2 = last ? nA : cA + (size_t)(t + 2) * kstep; const char* b2 = last ? nB : cB + (size_t)(t + 2) * kstep;
            const char* a3 = a2 + kstep; const char* b3 = b2 + kstep;
            if (last && has_next) S.a_ready(nxt);
            if constexpr (SP2) {
            PG8_LDB(B0, 0, 0); PG8_LDB(B1, 0, 1); PG8_SCHED; PG8_LDA(At, 0, 0); PG8_STAGE(PG8_SA(1, 1), a1 + hstep, voffA);
            PG8_WAIT_V(8); PG8_WAIT_L(0); PG8_BAR; PG8_MMA(0, 0, At, B0); PG8_MMA(0, 1, At, B1); PG8_BAR; PG8_SCHED;
            PG8_LDA(At, 0, 1); PG8_STAGE(PG8_SB(0, 0), b2, voffB); PG8_STAGE(PG8_SB(0, 1), b2 + hstep, voffB); PG8_STAGE(PG8_SA(0, 0), a2, voffA);
            PG8_WAIT_V(8); PG8_WAIT_L(0); PG8_BAR; PG8_MMA(1, 0, At, B0); PG8_MMA(1, 1, At, B1); PG8_BAR; PG8_SCHED;
            PG8_LDB(B0, 1, 0); PG8_LDB(B1, 1, 1); PG8_SCHED; PG8_LDA(At, 1, 0); PG8_STAGE(PG8_SA(0, 1), a2 + hstep, voffA);
            PG8_WAIT_V(8); PG8_WAIT_L(0); PG8_BAR; PG8_MMA(0, 0, At, B0); PG8_MMA(0, 1, At, B1); PG8_BAR; PG8_SCHED;
            PG8_LDA(At, 1, 1); PG8_STAGE(PG8_SB(1, 0), b3, voffB); PG8_STAGE(PG8_SB(1, 1), b3 + hstep, voffB); PG8_STAGE(PG8_SA(1, 0), a3, voffA);
            PG8_WAIT_V(8); PG8_WAIT_L(0); PG8_BAR; PG8_MMA(1, 0, At, B0); PG8_MMA(1, 1, At, B1); PG8_BAR; PG8_SCHED;
            } else {
            PG8_LDB(B0, 0, 0); PG8_SCHED; PG8_LDA(At, 0, 0); PG8_STAGE(PG8_SA(1, 1), a1 + hstep, voffA);
            PG8_WAIT_L(8); PG8_BAR; PG8_WAIT_L(0); PG8_MMA(0, 0, At, B0); PG8_BAR; PG8_SCHED;
            PG8_LDB(B1, 0, 1); PG8_STAGE(PG8_SB(0, 0), b2, voffB);
            PG8_BAR; PG8_WAIT_L(0); PG8_MMA(0, 1, At, B1); PG8_BAR;
            PG8_LDA(At, 0, 1); PG8_STAGE(PG8_SA(0, 0), a2, voffA);
            PG8_BAR; PG8_WAIT_L(0); PG8_MMA(1, 0, At, B0); PG8_BAR; PG8_SCHED;
            PG8_STAGE(PG8_SB(0, 1), b2 + hstep, voffB);
            PG8_WAIT_V(6); PG8_BAR; PG8_MMA(1, 1, At, B1); PG8_BAR;
            PG8_LDB(B0, 1, 0); PG8_SCHED; PG8_LDA(At, 1, 0); PG8_STAGE(PG8_SA(0, 1), a2 + hstep, voffA);
            PG8_WAIT_L(8); PG8_BAR; PG8_WAIT_L(0); PG8_MMA(0, 0, At, B0); PG8_BAR; PG8_SCHED;
            PG8_LDB(B1, 1, 1); PG8_STAGE(PG8_SB(1, 0), b3, voffB);
            PG8_BAR; PG8_WAIT_L(0); PG8_MMA(0, 1, At, B1); PG8_BAR;
            PG8_LDA(At, 1, 1); PG8_STAGE(PG8_SA(1, 0), a3, voffA);
            PG8_BAR; PG8_WAIT_L(0); PG8_MMA(1, 0, At, B0); PG8_BAR; PG8_SCHED;
            PG8_STAGE(PG8_SB(1, 1), b3 + hstep, voffB);
            PG8_WAIT_V(6); PG8_BAR; PG8_MMA(1, 1, At, B1); PG8_BAR;
            }
        }
        if constexpr (ALIGN_EPI) { if (wr == 0) PG8_BAR; }
        if constexpr (!Epi::AFTER_DRAIN) { E(acc, cur, wr, wc, fr, fq); S.done(cur); }
        if (!has_next) break;
#pragma unroll
        for (int a = 0; a < 2; ++a)
#pragma unroll
            for (int b = 0; b < 2; ++b)
#pragma unroll
                for (int m = 0; m < 4; ++m)
#pragma unroll
                    for (int n = 0; n < 2; ++n) acc[a][b][m][n] = (f32x4){0.f, 0.f, 0.f, 0.f};
        cur = nxt; cA = nA; cB = nB; ++ui;
        if constexpr (ALIGN_EPI) { if (wr == 1) PG8_BAR; }
    }
    PG8_WAIT_V(0);
    if constexpr (!ALIGN_EPI) { if (wr == 0) PG8_BAR; }
    PG8_BAR;
    if constexpr (Epi::AFTER_DRAIN) { E.fused(acc, cur, wr, wc, fr, fq, lds, wid, lane); S.done(cur); }
#undef PG8_SA
#undef PG8_SB
#undef PG8_STAGE
#undef PG8_LDA
#undef PG8_LDB
#undef PG8_MMA
#undef PG8_WAIT_V
#undef PG8_WAIT_L
#undef PG8_BAR
#undef PG8_SCHED
}
}
namespace cg = cooperative_groups;
#define GAS __attribute__((address_space(1)))
#define LAS __attribute__((address_space(3)))
typedef unsigned short bf16;
typedef unsigned v4u __attribute__((ext_vector_type(4)));
typedef unsigned v2u __attribute__((ext_vector_type(2)));
typedef float f32x4 __attribute__((ext_vector_type(4)));
typedef short bf16x8 __attribute__((ext_vector_type(8)));
typedef short s16x4 __attribute__((ext_vector_type(4)));

constexpr int NWAVES = 8;
constexpr int BATCH = 2, SEQ = 8192, D = 1024, M = BATCH * SEQ;
constexpr int WA = 512, WB = 768, WBO = 256, W_IN = 5888, DFF = 2816, NG = 2048;
constexpr int LDS_BYTES = 147456;
constexpr float LOG2E = 1.4426950408889634f, LN2 = 0.6931471805599453f;

constexpr size_t MiB = 1u << 20;
constexpr size_t WS_MOD = 1 * MiB;
constexpr size_t WS_ROPE = 1 * MiB + 256 * 1024;
constexpr size_t WS_WIN = 2 * MiB;
constexpr size_t WS_WPA = 15 * MiB, WS_WPB = 16 * MiB, WS_WO = 17 * MiB, WS_WF1 = 19 * MiB, WS_WF2 = 31 * MiB;
constexpr size_t WS_H = 38 * MiB;
constexpr size_t WS_QA = 70 * MiB, WS_KA = 86 * MiB, WS_VA = 102 * MiB, WS_QB = 118 * MiB, WS_KB = 142 * MiB, WS_VB = 166 * MiB, WS_G = 190 * MiB;
constexpr size_t WS_MERGED = 86 * MiB;
constexpr size_t WS_TMP = 118 * MiB;
constexpr size_t WS_ACT = 118 * MiB;
constexpr size_t WS_END = 254 * MiB;
static_assert(WS_WIN + (size_t)W_IN * D * 2 <= WS_WPA && WS_WF1 + (size_t)2 * DFF * D * 2 <= WS_WF2 && WS_WF2 + (size_t)D * DFF * 2 <= WS_H, "weights map");
static_assert(WS_G + (size_t)M * NG * 2 <= WS_END && WS_ACT + (size_t)M * DFF * 2 <= WS_END && WS_TMP + (size_t)M * D * 4 <= WS_G, "activation map");

#define LDS_WAIT() asm volatile("s_waitcnt lgkmcnt(0)" ::: "memory")
__device__ __forceinline__ unsigned f2bf(float f) { unsigned u = __builtin_bit_cast(unsigned, f); return (u + 0x7fffu + ((u >> 16) & 1u)) >> 16; }
__device__ __forceinline__ unsigned pk2(float lo, float hi) { return f2bf(lo) | (f2bf(hi) << 16); }
__device__ __forceinline__ float wave_sum(float v) {
#pragma unroll
    for (int o = 1; o < 64; o <<= 1) v += __shfl_xor(v, o);
    return v;
}

struct Args { const float* in[18]; float* out; unsigned char* ws; };

__device__ __forceinline__ void transpose_item(const float* W, int ldw, int K, bf16* WT, int src_n0, int dst_row0, int k0, LAS float* scr, int lane) {
#pragma unroll 8
    for (int i = 0; i < 32; ++i) { const int kk = 2 * i + (lane >> 5); scr[kk * 33 + (lane & 31)] = W[(size_t)(k0 + kk) * ldw + src_n0 + (lane & 31)]; }
    LDS_WAIT(); asm volatile("" ::: "memory");
    const int c = lane & 7;
#pragma unroll
    for (int j = 0; j < 4; ++j) { const int n = (lane >> 3) + 8 * j; const LAS float* s = scr + (8 * c) * 33 + n;
        v4u o; o.x = pk2(s[0 * 33], s[1 * 33]); o.y = pk2(s[2 * 33], s[3 * 33]); o.z = pk2(s[4 * 33], s[5 * 33]); o.w = pk2(s[6 * 33], s[7 * 33]);
        *(v4u*)(WT + (size_t)(dst_row0 + n) * K + k0 + 8 * c) = o; }
    LDS_WAIT(); asm volatile("" ::: "memory");
}

__device__ __forceinline__ void norm_row(const float* xrow, bf16* orow, const float* g, const float* sc, const float* sh, int lane) {
    f32x4 v[4]; float s = 0.f;
#pragma unroll
    for (int j = 0; j < 4; ++j) { v[j] = *((const f32x4*)xrow + lane + 64 * j); s += (v[j].x * v[j].x + v[j].y * v[j].y) + (v[j].z * v[j].z + v[j].w * v[j].w); }
    const float rstd = __builtin_amdgcn_rsqf(wave_sum(s) * (1.f / D) + 1e-6f);
#pragma unroll
    for (int j = 0; j < 4; ++j) { const int c = (lane + 64 * j);
        const f32x4 gg = *((const f32x4*)g + c), ss = *((const f32x4*)sc + c), hh = *((const f32x4*)sh + c);
        const f32x4 y = v[j] * rstd * gg * (ss + 1.0f) + hh;
        v2u o; o.x = pk2(y.x, y.y); o.y = pk2(y.z, y.w); *((v2u*)orow + c) = o; }
}

constexpr int VRS = 160;
__device__ __forceinline__ s16x4 tr_read(const LAS unsigned char* p) { return __builtin_bit_cast(s16x4, __builtin_amdgcn_ds_read_tr16_b64_v4i16((LAS s16x4*)p)); }
__device__ __forceinline__ bf16x8 pack_p(const f32x4 a, const f32x4 b) {
    v4u w; w.x = pg8::cvt_pk_bf16(a[0], a[1]); w.y = pg8::cvt_pk_bf16(a[2], a[3]); w.z = pg8::cvt_pk_bf16(b[0], b[1]); w.w = pg8::cvt_pk_bf16(b[2], b[3]); return __builtin_bit_cast(bf16x8, w);
}
#define MFMA16(a, b, c) __builtin_amdgcn_mfma_f32_16x16x32_bf16((a), (b), (c), 0, 0, 0)

__device__ __forceinline__ void pv_step(f32x4 (&O)[4], const LAS unsigned char* vl, const bf16x8 pf, int lane) {
    const int quad = lane >> 4, qq = (lane & 15) >> 2, p = lane & 3;
    const LAS unsigned char* b0 = vl + (4 * quad + qq) * VRS + p * 8;
#pragma unroll
    for (int c = 0; c < 4; ++c) {
        const s16x4 lo = tr_read(b0 + c * 32), hi = tr_read(b0 + 16 * VRS + c * 32);
        const bf16x8 vf = (bf16x8){lo[0], lo[1], lo[2], lo[3], hi[0], hi[1], hi[2], hi[3]};
        O[c] = MFMA16(vf, pf, O[c]);
    }
}

__device__ __forceinline__ void na_task(int tk, bf16* QA, const bf16* KA, const bf16* VA, const LAS float* rpbs, LAS unsigned char* vl, int lane) {
    const int qg = tk & 3, h = (tk >> 2) & 7, r = (tk >> 5) & 127, b = tk >> 12;
    const int q = lane & 15, quad = lane >> 4;
    const int wg0 = (qg == 0) ? 0 : (qg == 1) ? 8 : (qg == 2) ? 24 : 32;
    const int rs = min(max(r - 4, 0), 120);
    const size_t tq = (size_t)b * SEQ + r * 64 + 16 * qg + q;
    bf16* qptr = QA + tq * WA + h * 64;
    const bf16x8 qf0 = *(const bf16x8*)(qptr + 8 * quad), qf1 = *(const bf16x8*)(qptr + 32 + 8 * quad);
    const bf16* kbase = KA + ((size_t)b * SEQ + rs * 64 + wg0 + q) * WA + h * 64 + 8 * quad;
    const bf16* vbase = VA + ((size_t)b * SEQ + rs * 64 + wg0 + (lane >> 3)) * WA + h * 64 + (lane & 7) * 8;
    LAS unsigned char* vw = vl + (lane >> 3) * VRS + (lane & 7) * 16;
    v4u vr[4];
#pragma unroll
    for (int i = 0; i < 4; ++i) vr[i] = *(const v4u*)(vbase + (size_t)(8 * i) * WA);
    f32x4 S[16];
#pragma unroll
    for (int i = 0; i < 16; ++i) {
        const bf16* kp = kbase + (size_t)((i >> 1) * 64 + (i & 1) * 16) * WA;
        const bf16x8 k0 = *(const bf16x8*)kp, k1 = *(const bf16x8*)(kp + 32);
        f32x4 s = MFMA16(k0, qf0, ((f32x4){0.f, 0.f, 0.f, 0.f})); S[i] = MFMA16(k1, qf1, s);
    }
    const int qc = 16 * qg + q, cs = min(max(qc - 8, 0), 48);
    const LAS float* bp = rpbs + (h * 15 + (rs - r + 7)) * 31 + (wg0 + 4 * quad - qc + 15);
    float mx = -3.0e38f;
#pragma unroll
    for (int i = 0; i < 16; ++i)
#pragma unroll
        for (int e = 0; e < 4; ++e) {
            const int kc = wg0 + 16 * (i & 1) + 4 * quad + e;
            const float bv = bp[(i >> 1) * 31 + 16 * (i & 1) + e];
            float t = (S[i][e] + bv) * LOG2E;
            t = ((unsigned)(kc - cs) < 16u) ? t : -1.0e30f;
            S[i][e] = t; mx = fmaxf(mx, t);
        }
    mx = fmaxf(mx, __shfl_xor(mx, 16)); mx = fmaxf(mx, __shfl_xor(mx, 32));
    float l = 0.f;
#pragma unroll
    for (int i = 0; i < 16; ++i)
#pragma unroll
        for (int e = 0; e < 4; ++e) { const float p = __builtin_amdgcn_exp2f(S[i][e] - mx); S[i][e] = p; l += p; }
    l += __shfl_xor(l, 16); l += __shfl_xor(l, 32);
    f32x4 O[4];
#pragma unroll
    for (int c = 0; c < 4; ++c) O[c] = (f32x4){0.f, 0.f, 0.f, 0.f};
#pragma unroll
    for (int ks = 0; ks < 8; ++ks) {
#pragma unroll
        for (int i = 0; i < 4; ++i) *(LAS v4u*)(vw + 8 * i * VRS) = vr[i];
        if (ks < 7) {
#pragma unroll
            for (int i = 0; i < 4; ++i) vr[i] = *(const v4u*)(vbase + (size_t)((ks + 1) * 64 + 8 * i) * WA);
        }
        pv_step(O, vl, pack_p(S[2 * ks], S[2 * ks + 1]), lane);
    }
    const float rl = __builtin_amdgcn_rcpf(l);
#pragma unroll
    for (int c = 0; c < 4; ++c) { const f32x4 o = O[c] * rl; v2u w; w.x = pg8::cvt_pk_bf16(o[0], o[1]); w.y = pg8::cvt_pk_bf16(o[2], o[3]); *(v2u*)(qptr + 16 * c + 4 * quad) = w; }
}

__device__ __forceinline__ void dil_task(int g, int idx, bf16* QB, const bf16* KB, const bf16* VB, float* LSE, LAS unsigned char* vl, int lane) {
    const int sh = 2 * g, dil = 1 << sh, seg = SEQ >> sh, nblk = seg >> 4;
    const int jb = idx & (nblk - 1); int rest = idx >> (9 - sh); const int res = rest & (dil - 1); rest >>= sh; const int hg = rest & 3, b = rest >> 2, head = 4 * g + hg;
    const int q = lane & 15, quad = lane >> 4;
    const int lq = 16 * jb + q;
    const size_t tq = (size_t)b * SEQ + (size_t)lq * dil + res;
    bf16* qptr = QB + tq * WB + head * 64;
    const bf16x8 qf0 = *(const bf16x8*)(qptr + 8 * quad), qf1 = *(const bf16x8*)(qptr + 32 + 8 * quad);
    const int l0 = 16 * jb - 64;
    const bf16* kb0 = KB + ((size_t)b * SEQ + res) * WB + head * 64 + 8 * quad;
    const bf16* vb0 = VB + ((size_t)b * SEQ + res) * WB + head * 64 + (lane & 7) * 8;
    LAS unsigned char* vw = vl + (lane >> 3) * VRS + (lane & 7) * 16;
    v4u vr[4];
#pragma unroll
    for (int i = 0; i < 4; ++i) { const int lk = min(max(l0 + (lane >> 3) + 8 * i, 0), seg - 1); vr[i] = *(const v4u*)(vb0 + (size_t)lk * dil * WB); }
    f32x4 S[10];
#pragma unroll
    for (int i = 0; i < 9; ++i) {
        const int lk = min(max(l0 + 16 * i + q, 0), seg - 1);
        const bf16* kp = kb0 + (size_t)lk * dil * WB;
        const bf16x8 k0 = *(const bf16x8*)kp, k1 = *(const bf16x8*)(kp + 32);
        f32x4 s = MFMA16(k0, qf0, ((f32x4){0.f, 0.f, 0.f, 0.f})); S[i] = MFMA16(k1, qf1, s);
    }
    S[9] = (f32x4){0.f, 0.f, 0.f, 0.f};
    float mx = -3.0e38f;
#pragma unroll
    for (int i = 0; i < 9; ++i)
#pragma unroll
        for (int e = 0; e < 4; ++e) {
            const int lk = l0 + 16 * i + 4 * quad + e, dd = lk - lq;
            const bool valid = (lk >= 0) && (lk < seg) && (dd <= 64) && (dd >= -64);
            const float t = valid ? S[i][e] * LOG2E : -1.0e30f;
            S[i][e] = t; mx = fmaxf(mx, t);
        }
    mx = fmaxf(mx, __shfl_xor(mx, 16)); mx = fmaxf(mx, __shfl_xor(mx, 32));
    float l = 0.f;
#pragma unroll
    for (int i = 0; i < 9; ++i)
#pragma unroll
        for (int e = 0; e < 4; ++e) { const float p = __builtin_amdgcn_exp2f(S[i][e] - mx); S[i][e] = p; l += p; }
    l += __shfl_xor(l, 16); l += __shfl_xor(l, 32);
    f32x4 O[4];
#pragma unroll
    for (int c = 0; c < 4; ++c) O[c] = (f32x4){0.f, 0.f, 0.f, 0.f};
#pragma unroll
    for (int ks = 0; ks < 5; ++ks) {
#pragma unroll
        for (int i = 0; i < 4; ++i) *(LAS v4u*)(vw + 8 * i * VRS) = vr[i];
        if (ks < 4) {
#pragma unroll
            for (int i = 0; i < 4; ++i) { const int lk = min(max(l0 + 32 * (ks + 1) + (lane >> 3) + 8 * i, 0), seg - 1); vr[i] = *(const v4u*)(vb0 + (size_t)lk * dil * WB); }
        }
        pv_step(O, vl, pack_p(S[2 * ks], S[2 * ks + 1]), lane);
    }
    const float rl = __builtin_amdgcn_rcpf(l);
#pragma unroll
    for (int c = 0; c < 4; ++c) { const f32x4 o = O[c] * rl; v2u w; w.x = pg8::cvt_pk_bf16(o[0], o[1]); w.y = pg8::cvt_pk_bf16(o[2], o[3]); *(v2u*)(qptr + 16 * c + 4 * quad) = w; }
    if (quad == 0) LSE[tq * 12 + head] = (mx + __builtin_amdgcn_logf(l)) * LN2;
}

__global__ void __launch_bounds__(NWAVES * 64, 2) enc_fwd(Args args) {
    extern __shared__ __attribute__((aligned(16))) unsigned char lds_raw[];
    cg::grid_group grid = cg::this_grid();
    LAS unsigned char* lds = (LAS unsigned char*)lds_raw;
    const int tid = threadIdx.x, lane = tid & 63, wave = __builtin_amdgcn_readfirstlane(tid >> 6);
    const int G = gridDim.x, bx = blockIdx.x;
    const int vcu = (G % 8 == 0) ? (bx % 8) * (G / 8) + bx / 8 : bx;
    const int gw = vcu * NWAVES + wave, NGW = G * NWAVES;
    unsigned char* ws = args.ws;
    const float *x = args.in[0], *c = args.in[1], *w_ada = args.in[2], *b_ada = args.in[3], *g_norm1 = args.in[4], *g_norm2 = args.in[5], *w_in = args.in[6], *b_gate = args.in[7];
    const float *g_qa = args.in[8], *g_ka = args.in[9], *g_qb = args.in[10], *g_kb = args.in[11], *rpb = args.in[12], *w_pa = args.in[13], *w_pb = args.in[14], *w_o = args.in[15], *w_f1 = args.in[16], *w_f2 = args.in[17];
    float* out = args.out;
    float* MOD = (float*)(ws + WS_MOD); float* ROPE = (float*)(ws + WS_ROPE);
    bf16 *WIN = (bf16*)(ws + WS_WIN), *WPA = (bf16*)(ws + WS_WPA), *WPB = (bf16*)(ws + WS_WPB), *WO = (bf16*)(ws + WS_WO), *WF1 = (bf16*)(ws + WS_WF1), *WF2 = (bf16*)(ws + WS_WF2);
    bf16 *H = (bf16*)(ws + WS_H), *QA = (bf16*)(ws + WS_QA), *KA = (bf16*)(ws + WS_KA), *VA = (bf16*)(ws + WS_VA), *QB = (bf16*)(ws + WS_QB), *KB = (bf16*)(ws + WS_KB), *VB = (bf16*)(ws + WS_VB), *GT = (bf16*)(ws + WS_G);
    float* LSE = (float*)(ws + WS_H); bf16* OB = (bf16*)(ws + WS_H + 1 * MiB);
    bf16* MERGED = (bf16*)(ws + WS_MERGED); float* TMP = (float*)(ws + WS_TMP); bf16* ACT = (bf16*)(ws + WS_ACT);

    {
        LAS float* scr = (LAS float*)(lds + wave * 16384);
        constexpr int I_IN = 16 * (W_IN / 32), I_PA = 8 * 32, I_PB = 4 * 32, I_O = 16 * 32, I_F1 = 16 * (2 * DFF / 32), I_F2 = (DFF / 64) * 32;
        constexpr int NITEMS = I_IN + I_PA + I_PB + I_O + I_F1 + I_F2;
        for (int it = gw; it < NITEMS; it += NGW) {
            int r = it;
            if (r < I_IN) { const int nb = r % (W_IN / 32), kb = r / (W_IN / 32), pn = nb >> 3, g8 = nb & 7, bj = g8 >> 2, wc = g8 & 3;
                transpose_item(w_in, W_IN, D, WIN, 256 * pn + 64 * wc + 32 * bj, 32 * nb, 64 * kb, scr, lane); continue; } r -= I_IN;
            if (r < I_PA) { transpose_item(w_pa, D, WA, WPA, 32 * (r % 32), 32 * (r % 32), 64 * (r / 32), scr, lane); continue; } r -= I_PA;
            if (r < I_PB) { transpose_item(w_pb, D, WBO, WPB, 32 * (r % 32), 32 * (r % 32), 64 * (r / 32), scr, lane); continue; } r -= I_PB;
            if (r < I_O) { transpose_item(w_o, D, D, WO, 32 * (r % 32), 32 * (r % 32), 64 * (r / 32), scr, lane); continue; } r -= I_O;
            if (r < I_F1) { const int nb = r % (2 * DFF / 32), kb = r / (2 * DFF / 32), pn = nb >> 3, g8 = nb & 7, bj = g8 >> 2, j32 = g8 & 3;
                transpose_item(w_f1, 2 * DFF, D, WF1, bj * DFF + 128 * pn + 32 * j32, 32 * nb, 64 * kb, scr, lane); continue; } r -= I_F1;
            transpose_item(w_f2, D, DFF, WF2, 32 * (r % 32), 32 * (r % 32), 64 * (r / 32), scr, lane);
        }
        for (int e = bx * 512 + tid; e < SEQ * 8; e += G * 512) {
            const int pos = e >> 3, i = e & 7;
            const double ir = (i == 0) ? 0.15915494309189535 : (i == 1) ? 0.03086376340470123 : (i == 2) ? 0.005985185712713705 : (i == 3) ? 0.001160663641240061 :
                              (i == 4) ? 0.00022507907903927653 : (i == 5) ? 4.364795279280289e-05 : (i == 6) ? 8.464330808241401e-06 : 1.6414262627950345e-06;
            const double rev = (double)pos * ir; const float fr = (float)(rev - __builtin_floor(rev));
            ROPE[pos * 16 + i] = __builtin_amdgcn_cosf(fr); ROPE[pos * 16 + 8 + i] = __builtin_amdgcn_sinf(fr);
        }
        __syncthreads();
        if (bx < 96) {
            const int n = 64 * bx + lane; float a0 = 0.f, a1 = 0.f;
#pragma unroll 8
            for (int k = 128 * wave; k < 128 * wave + 128; ++k) {
                const float wv = w_ada[(size_t)k * 6144 + n]; const float c0 = c[k], c1 = c[D + k];
                a0 += (c0 * __builtin_amdgcn_rcpf(1.0f + __expf(-c0))) * wv; a1 += (c1 * __builtin_amdgcn_rcpf(1.0f + __expf(-c1))) * wv;
            }
            LAS float* red = (LAS float*)lds;
            red[(wave * 2 + 0) * 64 + lane] = a0; red[(wave * 2 + 1) * 64 + lane] = a1;
            __syncthreads();
            if (wave < 2) { float s = b_ada[n];
#pragma unroll
                for (int w = 0; w < 8; ++w) s += red[(w * 2 + wave) * 64 + lane];
                MOD[wave * 6144 + n] = s; }
        }
    }
    grid.sync();
    { int ln = lane; asm volatile("" : "+v"(ln));
      for (int m = gw; m < M; m += NGW) { const float* mb = MOD + (size_t)(m >> 13) * 6144; norm_row(x + (size_t)m * D, H + (size_t)m * D, g_norm1, mb + 1024, mb, ln); } }
    grid.sync();
    {
        pg8::Gemm g{H, WIN, M, W_IN, D}; pg8::StaticOrder S; S.init(M, W_IN, G, bx);
        pg8::EpiIn E{QA, KA, VA, QB, KB, VB, GT, g_qa, g_ka, g_qb, g_kb, b_gate, ROPE};
        pg8::gemm_phase<pg8::EpiIn, pg8::StaticOrder, true, true>(lds, g, S, E);
    }
    grid.sync();
    {
        LAS float* rpbs = (LAS float*)lds;
        for (int i = tid; i < 3720; i += 512) rpbs[64 + i] = rpb[i];
        __syncthreads();
        LAS unsigned char* vl = lds + 16384 + wave * 5120;
        int lane_ = lane; asm volatile("" : "+v"(lane_));
        for (int tk = gw; tk < 8192; tk += NGW) na_task(tk, QA, KA, VA, rpbs + 64, vl, lane_);
        for (int tk = gw; tk < 12288; tk += NGW) dil_task(tk >> 12, tk & 4095, QB, KB, VB, LSE, vl, lane_);
    }
    grid.sync();
    int tid3 = tid; asm volatile("" : "+v"(tid3));
    for (int e = bx * 512 + tid3; e < M * 32; e += G * 512) {
        const int tok = e >> 5, hg = (e >> 3) & 3, ch = e & 7;
        const float l0 = LSE[(size_t)tok * 12 + hg], l1 = LSE[(size_t)tok * 12 + 4 + hg], l2 = LSE[(size_t)tok * 12 + 8 + hg];
        const float mxl = fmaxf(l0, fmaxf(l1, l2)); float w0 = __expf(l0 - mxl), w1 = __expf(l1 - mxl), w2 = __expf(l2 - mxl); const float rs = 1.0f / (w0 + w1 + w2); w0 *= rs; w1 *= rs; w2 *= rs;
        const bf16* op = QB + (size_t)tok * WB + hg * 64 + ch * 8;
        const v4u a = *(const v4u*)op, b = *(const v4u*)(op + 256), cc = *(const v4u*)(op + 512);
        v4u o;
#define MRG(f) pk2(w0 * pg8::bf_lo(a.f) + w1 * pg8::bf_lo(b.f) + w2 * pg8::bf_lo(cc.f), w0 * pg8::bf_hi(a.f) + w1 * pg8::bf_hi(b.f) + w2 * pg8::bf_hi(cc.f))
        o.x = MRG(x); o.y = MRG(y); o.z = MRG(z); o.w = MRG(w);
#undef MRG
        *(v4u*)(OB + (size_t)tok * WBO + hg * 64 + ch * 8) = o;
    }
    grid.sync();
    {
        pg8::StaticOrder S; S.init(M, D, G, bx);
        { pg8::Gemm g{QA, WPA, M, D, WA}; pg8::EpiGateA E{GT, NG, TMP}; pg8::gemm_phase<pg8::EpiGateA, pg8::StaticOrder, true, true>(lds, g, S, E); }
        { pg8::Gemm g{OB, WPB, M, D, WBO}; pg8::EpiGateB E{GT + 1024, NG, TMP, MERGED}; pg8::gemm_phase<pg8::EpiGateB, pg8::StaticOrder, true, true>(lds, g, S, E); }
    }
    grid.sync();
    {
        pg8::Gemm g{MERGED, WO, M, D, D}; pg8::StaticOrder S; S.init(M, D, G, bx);
        pg8::EpiRes E{x, out, MOD + 2048}; pg8::gemm_phase<pg8::EpiRes, pg8::StaticOrder, true, true>(lds, g, S, E);
    }
    grid.sync();
    { int ln = lane; asm volatile("" : "+v"(ln));
      for (int m = gw; m < M; m += NGW) { const float* mb = MOD + (size_t)(m >> 13) * 6144; norm_row(out + (size_t)m * D, H + (size_t)m * D, g_norm2, mb + 4096, mb + 3072, ln); } }
    grid.sync();
    {
        pg8::Gemm g{H, WF1, M, 2 * DFF, D}; pg8::StaticOrder S; S.init(M, 2 * DFF, G, bx);
        pg8::EpiSwiglu E{ACT, DFF}; pg8::gemm_phase<pg8::EpiSwiglu, pg8::StaticOrder, true, true>(lds, g, S, E);
    }
    grid.sync();
    {
        pg8::Gemm g{ACT, WF2, M, D, DFF}; pg8::StaticOrder S; S.init(M, D, G, bx);
        pg8::EpiRes E{out, out, MOD + 5120}; pg8::gemm_phase<pg8::EpiRes, pg8::StaticOrder, true, true>(lds, g, S, E);
    }
}

extern "C" void kernel_launch(void* const* d_in, const int* in_sizes, int n_in, void* d_out, int out_size, void* d_ws, size_t ws_size, hipStream_t stream) {
    static int grid = 0;
    if (grid == 0) {
        if (n_in != 18 || in_sizes[0] != M * D || out_size != M * D || ws_size < WS_END) { fprintf(stderr, "kernel_launch: unexpected shapes (n_in %d, in0 %d, out %d, ws %zu); nothing launched\n", n_in, n_in > 0 ? in_sizes[0] : -1, out_size, ws_size); grid = -1; return; }
        int dev = 0, cus = 0, per_cu = 0;
        if (hipGetDevice(&dev) != hipSuccess || hipDeviceGetAttribute(&cus, hipDeviceAttributeMultiprocessorCount, dev) != hipSuccess) { grid = -1; return; }
        if (hipFuncSetAttribute((const void*)enc_fwd, hipFuncAttributeMaxDynamicSharedMemorySize, LDS_BYTES) != hipSuccess) { fprintf(stderr, "kernel_launch: hipFuncSetAttribute failed\n"); grid = -1; return; }
        if (hipOccupancyMaxActiveBlocksPerMultiprocessor(&per_cu, (const void*)enc_fwd, NWAVES * 64, LDS_BYTES) != hipSuccess || per_cu < 1) { fprintf(stderr, "kernel_launch: occupancy query gave %d\n", per_cu); (void)hipGetLastError(); per_cu = 1; }
        grid = cus * 1;
        (void)per_cu;
    }
    if (grid < 0) return;
    Args a{};
    for (int i = 0; i < 18; ++i) a.in[i] = (const float*)d_in[i];
    a.out = (float*)d_out; a.ws = (unsigned char*)d_ws;
    void* kargs[] = {&a};
    const hipError_t le = hipLaunchCooperativeKernel((const void*)enc_fwd, dim3(grid), dim3(NWAVES * 64), kargs, LDS_BYTES, stream);
    if (le != hipSuccess) fprintf(stderr, "kernel_launch: cooperative launch failed: %s (grid %d)\n", hipGetErrorName(le), grid);
}
```

```cpp
#include <hip/hip_runtime.h>
#include <hip/hip_cooperative_groups.h>
#include <cstdio>
#include <cstdint>
namespace pg8 {
#define PG8_LAS __attribute__((address_space(3)))
typedef unsigned short bf16_t;
typedef short bf16x8 __attribute__((ext_vector_type(8)));
typedef float f32x4 __attribute__((ext_vector_type(4)));
typedef unsigned u32x4 __attribute__((ext_vector_type(4)));
constexpr int BM = 256, BK = 64, HALF = 128, HTB = HALF * BK * 2  , STAGE_BYTES = 8 * HTB, NXCD = 8, WGM = 8;

__host__ __device__ __forceinline__ int lds_byte(int r, int c) { const int st = (r >> 4) * 2 + (c >> 5), rr = r & 15, cc = c & 31, ob = rr * 64 + cc * 2; return st * 1024 + (ob ^ (((ob >> 9) & 1) << 5)); }
__host__ __device__ __forceinline__ void stage_rc(int b, int& R, int& C) { const int st = b / 1024, sb = b % 1024, swz = sb ^ (((sb >> 9) & 1) << 5); R = (st >> 1) * 16 + swz / 64; C = (st & 1) * 32 + (swz % 64) / 2; }
__host__ __device__ __forceinline__ int perm32(int rho) { const int n = rho >> 4, i = rho & 15; return 8 * (i >> 2) + 4 * n + (i & 3); }

struct Unit { int pm, pn; };
struct Gemm { const bf16_t* A; const bf16_t* Bt; int M, N, K; };

struct StaticOrder {
    int nM, nN, nwg, G, c;
    __host__ __device__ void init(int M, int N, int G_, int c_) { nM = M / BM; nN = N / BM; nwg = nM * nN; G = G_; c = c_; }
    __host__ __device__ bool next(int i, Unit& u) const {
        const long L = (long)i * G + c; if (L >= nwg) return false;
        int wgid = (int)L; { const int q = nwg / NXCD, r = nwg % NXCD, xcd = wgid % NXCD, off = wgid / NXCD; wgid = (xcd < r ? xcd * (q + 1) : r * (q + 1) + (xcd - r) * q) + off; }
        const int nig = WGM * nN, gid = wgid / nig, fm = gid * WGM, gsz = (nM - fm) < WGM ? (nM - fm) : WGM;
        u.pm = fm + ((wgid % nig) % gsz); u.pn = (wgid % nig) / gsz; return true;
    }
    __device__ __forceinline__ void a_ready(const Unit&) const {}
    __device__ __forceinline__ void done(const Unit&) const {}
};

__device__ __forceinline__ unsigned cvt_pk_bf16(float lo, float hi) { unsigned r; asm volatile("v_cvt_pk_bf16_f32 %0, %1, %2" : "=v"(r) : "v"(lo), "v"(hi)); return r; }
typedef float f32x2 __attribute__((ext_vector_type(2)));
__device__ __forceinline__ u32x4 pack8(const f32x4 a, const f32x4 b) { u32x4 w; w.x = cvt_pk_bf16(a[0], a[1]); w.y = cvt_pk_bf16(a[2], a[3]); w.z = cvt_pk_bf16(b[0], b[1]); w.w = cvt_pk_bf16(b[2], b[3]); return w; }
__device__ __forceinline__ float bf_lo(unsigned w) { return __uint_as_float(w << 16); }
__device__ __forceinline__ float bf_hi(unsigned w) { return __uint_as_float(w & 0xffff0000u); }

struct EpiIn {
    static constexpr bool PERM = true, AFTER_DRAIN = false;
    bf16_t *QA, *KA, *VA, *QB, *KB, *VB, *G;
    const float *g_qa, *g_ka, *g_qb, *g_kb, *b_gate, *rope;
    __device__ __forceinline__ void operator()(const f32x4 (&acc)[2][2][4][2], const Unit& u, int wr, int wc, int fr, int fq) const {
        asm volatile("" : "+v"(fr), "+v"(fq));
        const int pn = u.pn;
        bf16_t* base; int ldc, ct0, kind; const float* gw = g_qa; float qs = 1.0f;
        if (pn < 2)       { base = QA; ldc = 512;  ct0 = pn * 256;        kind = 1; gw = g_qa; qs = 0.125f; }
        else if (pn < 4)  { base = KA; ldc = 512;  ct0 = (pn - 2) * 256;  kind = 1; gw = g_ka; }
        else if (pn < 6)  { base = VA; ldc = 512;  ct0 = (pn - 4) * 256;  kind = 0; }
        else if (pn < 9)  { base = QB; ldc = 768;  ct0 = (pn - 6) * 256;  kind = 2; gw = g_qb; qs = 0.125f; }
        else if (pn < 12) { base = KB; ldc = 768;  ct0 = (pn - 9) * 256;  kind = 2; gw = g_kb; }
        else if (pn < 15) { base = VB; ldc = 768;  ct0 = (pn - 12) * 256; kind = 0; }
        else              { base = G;  ldc = 2048; ct0 = (pn - 15) * 256; kind = 3; }
        const int cw = ct0 + 64 * wc + 8 * fq;
        f32x4 wv[2][2];
#pragma unroll
        for (int bj = 0; bj < 2; ++bj)
#pragma unroll
            for (int n = 0; n < 2; ++n) {
                if (kind == 3) wv[bj][n] = *(const f32x4*)(b_gate + cw + 32 * bj + 4 * n);
                else wv[bj][n] = *(const f32x4*)(gw + 32 * bj + 8 * fq + 4 * n) * qs;
            }
#pragma unroll
        for (int ai = 0; ai < 2; ++ai)
#pragma unroll
            for (int m = 0; m < 4; ++m) {
                const int row = u.pm * BM + ai * HALF + wr * 64 + m * 16 + fr;
                f32x4 v[2][2];
#pragma unroll
                for (int bj = 0; bj < 2; ++bj)
#pragma unroll
                    for (int n = 0; n < 2; ++n) v[bj][n] = acc[ai][bj][m][n];
                if (kind == 1 || kind == 2) {
                    float ss = 0.f;
#pragma unroll
                    for (int bj = 0; bj < 2; ++bj)
#pragma unroll
                        for (int n = 0; n < 2; ++n) { const f32x4 x = v[bj][n]; ss += (x[0] * x[0] + x[1] * x[1]) + (x[2] * x[2] + x[3] * x[3]); }
                    ss += __shfl_xor(ss, 16); ss += __shfl_xor(ss, 32);
                    const float rstd = __builtin_amdgcn_rsqf(ss * (1.0f / 64.0f) + 1e-6f);
#pragma unroll
                    for (int bj = 0; bj < 2; ++bj)
#pragma unroll
                        for (int n = 0; n < 2; ++n) v[bj][n] = v[bj][n] * rstd * wv[bj][n];
                    if (kind == 2) {
                        const float* rp = rope + (size_t)(row & 8191) * 16;
                        const f32x4 c0 = *(const f32x4*)(rp), c1 = *(const f32x4*)(rp + 4), s0 = *(const f32x4*)(rp + 8), s1 = *(const f32x4*)(rp + 12);
                        f32x4 p0, p1;
#pragma unroll
                        for (int e = 0; e < 4; ++e) { p0[e] = __shfl_xor(v[0][0][e], 16); p1[e] = __shfl_xor(v[0][1][e], 16); }
                        if (fq == 0)      { v[0][0] = v[0][0] * c0 - p0 * s0; v[0][1] = v[0][1] * c1 - p1 * s1; }
                        else if (fq == 1) { v[0][0] = v[0][0] * c0 + p0 * s0; v[0][1] = v[0][1] * c1 + p1 * s1; }
                    }
                } else if (kind == 3) {
#pragma unroll
                    for (int bj = 0; bj < 2; ++bj)
#pragma unroll
                        for (int n = 0; n < 2; ++n)
#pragma unroll
                            for (int e = 0; e < 4; ++e) { const float x = v[bj][n][e] + wv[bj][n][e]; v[bj][n][e] = __builtin_amdgcn_rcpf(1.0f + __expf(-x)); }
                }
                bf16_t* rowp = base + (size_t)row * ldc + cw;
#pragma unroll
                for (int bj = 0; bj < 2; ++bj) *(u32x4*)(rowp + 32 * bj) = pack8(v[bj][0], v[bj][1]);
            }
    }
};

struct EpiGateA {
    static constexpr bool PERM = true, AFTER_DRAIN = false;
    const bf16_t* G; int ldg; float* T;
    __device__ __forceinline__ void operator()(const f32x4 (&acc)[2][2][4][2], const Unit& u, int wr, int wc, int fr, int fq) const {
        asm volatile("" : "+v"(fr), "+v"(fq));
        const int col0 = u.pn * BM + wc * 32 + 8 * fq;
#pragma unroll
        for (int ai = 0; ai < 2; ++ai)
#pragma unroll
            for (int m = 0; m < 4; ++m) { const size_t row = (size_t)(u.pm * BM + ai * HALF + wr * 64 + m * 16 + fr);
#pragma unroll
                for (int bj = 0; bj < 2; ++bj) { const u32x4 g = *(const u32x4*)(G + row * ldg + col0 + bj * HALF);
                    f32x4 a = acc[ai][bj][m][0], b = acc[ai][bj][m][1];
                    a[0] *= bf_lo(g.x); a[1] *= bf_hi(g.x); a[2] *= bf_lo(g.y); a[3] *= bf_hi(g.y); b[0] *= bf_lo(g.z); b[1] *= bf_hi(g.z); b[2] *= bf_lo(g.w); b[3] *= bf_hi(g.w);
                    float* tp = T + row * 1024 + col0 + bj * HALF; *(f32x4*)tp = a; *(f32x4*)(tp + 4) = b; }
                asm volatile("" ::: "memory"); }
    }
};
struct EpiGateB {
    static constexpr bool PERM = true, AFTER_DRAIN = false;
    const bf16_t* G; int ldg; const float* T; bf16_t* O;
    __device__ __forceinline__ void operator()(const f32x4 (&acc)[2][2][4][2], const Unit& u, int wr, int wc, int fr, int fq) const {
        asm volatile("" : "+v"(fr), "+v"(fq));
        const int col0 = u.pn * BM + wc * 32 + 8 * fq;
#pragma unroll
        for (int ai = 0; ai < 2; ++ai)
#pragma unroll
            for (int m = 0; m < 4; ++m) { const size_t row = (size_t)(u.pm * BM + ai * HALF + wr * 64 + m * 16 + fr);
#pragma unroll
                for (int bj = 0; bj < 2; ++bj) { const u32x4 g = *(const u32x4*)(G + row * ldg + col0 + bj * HALF);
                    const float* tp = T + row * 1024 + col0 + bj * HALF; const f32x4 t0 = *(const f32x4*)tp, t1 = *(const f32x4*)(tp + 4);
                    f32x4 a = acc[ai][bj][m][0], b = acc[ai][bj][m][1];
                    a[0] = t0[0] + a[0] * bf_lo(g.x); a[1] = t0[1] + a[1] * bf_hi(g.x); a[2] = t0[2] + a[2] * bf_lo(g.y); a[3] = t0[3] + a[3] * bf_hi(g.y);
                    b[0] = t1[0] + b[0] * bf_lo(g.z); b[1] = t1[1] + b[1] * bf_hi(g.z); b[2] = t1[2] + b[2] * bf_lo(g.w); b[3] = t1[3] + b[3] * bf_hi(g.w);
                    *(u32x4*)(O + row * 1024 + col0 + bj * HALF) = pack8(a, b); asm volatile("" ::: "memory"); } }
    }
};
struct EpiRes {
    static constexpr bool PERM = false, AFTER_DRAIN = false;
    const float* base; float* out; const float* gt; float oscale;
    __device__ __forceinline__ void operator()(const f32x4 (&acc)[2][2][4][2], const Unit& u, int wr, int wc, int fr, int fq) const {
        asm volatile("" : "+v"(fr), "+v"(fq));
        const int col0 = u.pn * BM + wc * 32 + 4 * fq; const float* gb = gt + (size_t)(u.pm >> 5) * 6144;
        f32x4 gv[2][2];
#pragma unroll
        for (int bj = 0; bj < 2; ++bj)
#pragma unroll
            for (int n = 0; n < 2; ++n) gv[bj][n] = *(const f32x4*)(gb + col0 + bj * HALF + n * 16);
#pragma unroll
        for (int ai = 0; ai < 2; ++ai)
#pragma unroll
            for (int m = 0; m < 4; ++m) { const size_t off = (size_t)(u.pm * BM + ai * HALF + wr * 64 + m * 16 + fr) * 1024 + col0;
#pragma unroll
                for (int bj = 0; bj < 2; ++bj)
#pragma unroll
                    for (int n = 0; n < 2; ++n) { const f32x4 bs = *(const f32x4*)(base + off + bj * HALF + n * 16); *(f32x4*)(out + off + bj * HALF + n * 16) = (bs + gv[bj][n] * acc[ai][bj][m][n]) * oscale; } }
    }
};
struct EpiSwiglu {
    static constexpr bool PERM = true, AFTER_DRAIN = false;
    bf16_t* O; int ldc;
    __device__ __forceinline__ void operator()(const f32x4 (&acc)[2][2][4][2], const Unit& u, int wr, int wc, int fr, int fq) const {
        asm volatile("" : "+v"(fr), "+v"(fq));
        const int col0 = u.pn * HALF + wc * 32 + 8 * fq;
#pragma unroll
        for (int ai = 0; ai < 2; ++ai)
#pragma unroll
            for (int m = 0; m < 4; ++m) { const size_t row = (size_t)(u.pm * BM + ai * HALF + wr * 64 + m * 16 + fr);
                f32x4 r[2];
#pragma unroll
                for (int n = 0; n < 2; ++n)
#pragma unroll
                    for (int e = 0; e < 4; ++e) { const float a = acc[ai][0][m][n][e], up = acc[ai][1][m][n][e]; r[n][e] = a * __builtin_amdgcn_rcpf(1.0f + __expf(-a)) * up; }
                *(u32x4*)(O + row * ldc + col0) = pack8(r[0], r[1]); }
    }
};
template <class Epi, class Sched, bool ALIGN_EPI = false, bool SP2 = false>
__device__ __forceinline__ void gemm_phase(PG8_LAS unsigned char* lds, const Gemm g, const Sched& S, const Epi& E) {
    int tid_ = threadIdx.x; asm volatile("" : "+v"(tid_));
    const int tid = tid_, wid = __builtin_amdgcn_readfirstlane(tid >> 6), lane = tid & 63, wr = wid >> 2, wc = wid & 3, fr = lane & 15, fq = lane >> 4;
    const int K = g.K, nt = K / BK;
    unsigned voffA[2], voffB[2];
#pragma unroll
    for (int i = 0; i < 2; ++i) { int R, C; stage_rc(tid * 16 + i * 8192, R, C); const int Rb = Epi::PERM ? ((R & ~31) + perm32(R & 31)) : R;
        voffA[i] = (unsigned)(R * K + C) * 2u; voffB[i] = (unsigned)(Rb * K + C) * 2u; }
    const size_t kstep = (size_t)(BK * 2);
    const size_t hstep = (size_t)HALF * K * 2;
    const size_t tstep = 2 * hstep;
    const unsigned ldsw = (unsigned)wid * 1024u;
    const int aoff = lds_byte(wr * 64 + fr, fq * 8), boff = lds_byte(wc * 32 + fr, fq * 8);
#define PG8_SA(b, h) (((b) * 2 + (h)) * HTB)
#define PG8_SB(b, h) ((4 + (b) * 2 + (h)) * HTB)
#define PG8_STAGE(bufoff, gbase, voff) do { _Pragma("unroll") for (int _i = 0; _i < 2; ++_i) \
        __builtin_amdgcn_global_load_lds((const unsigned*)((const char*)(gbase) + (voff)[_i]), (PG8_LAS unsigned*)(lds + (bufoff) + ldsw + _i * 8192), 16, 0, 0); } while (0)
#define PG8_LDA(dst, b, h) do { _Pragma("unroll") for (int m = 0; m < 4; ++m) _Pragma("unroll") for (int k = 0; k < 2; ++k) dst[m][k] = *(const PG8_LAS bf16x8*)(lds + PG8_SA(b, h) + aoff + m * 2048 + k * 1024); } while (0)
#define PG8_LDB(dst, b, h) do { _Pragma("unroll") for (int n = 0; n < 2; ++n) _Pragma("unroll") for (int k = 0; k < 2; ++k) dst[n][k] = *(const PG8_LAS bf16x8*)(lds + PG8_SB(b, h) + boff + n * 2048 + k * 1024); } while (0)
#define PG8_MMA(ai, bj, At, Bt) do { __builtin_amdgcn_s_setprio(1); _Pragma("unroll") for (int m = 0; m < 4; ++m) _Pragma("unroll") for (int n = 0; n < 2; ++n) _Pragma("unroll") for (int k = 0; k < 2; ++k) \
        acc[ai][bj][m][n] = __builtin_amdgcn_mfma_f32_16x16x32_bf16(Bt[n][k], At[m][k], acc[ai][bj][m][n], 0, 0, 0); __builtin_amdgcn_s_setprio(0); } while (0)
#define PG8_WAIT_V(n) asm volatile("s_waitcnt vmcnt(" #n ")" ::: "memory")
#define PG8_WAIT_L(n) asm volatile("s_waitcnt lgkmcnt(" #n ")" ::: "memory")
#define PG8_BAR __builtin_amdgcn_s_barrier()
#define PG8_SCHED __builtin_amdgcn_sched_barrier(0)
    Unit cur, nxt; int ui = 0;
    if (!S.next(0, cur)) return;
    f32x4 acc[2][2][4][2];
#pragma unroll
    for (int a = 0; a < 2; ++a)
#pragma unroll
        for (int b = 0; b < 2; ++b)
#pragma unroll
            for (int m = 0; m < 4; ++m)
#pragma unroll
                for (int n = 0; n < 2; ++n) acc[a][b][m][n] = (f32x4){0.f, 0.f, 0.f, 0.f};
    bf16x8 At[4][2], B0[2][2], B1[2][2];
    const char* cA = (const char*)g.A + (size_t)cur.pm * tstep; const char* cB = (const char*)g.Bt + (size_t)cur.pn * tstep;
    S.a_ready(cur);
    if constexpr (SP2) {
        PG8_STAGE(PG8_SB(0, 0), cB, voffB); PG8_STAGE(PG8_SB(0, 1), cB + hstep, voffB); PG8_STAGE(PG8_SA(0, 0), cA, voffA); PG8_STAGE(PG8_SA(0, 1), cA + hstep, voffA);
        if (wr == 1) PG8_BAR;
        PG8_WAIT_V(2); PG8_BAR;
        PG8_STAGE(PG8_SB(1, 0), cB + kstep, voffB); PG8_STAGE(PG8_SA(1, 0), cA + kstep, voffA); PG8_STAGE(PG8_SB(1, 1), cB + hstep + kstep, voffB);
        PG8_WAIT_V(6); PG8_BAR;
    } else {
        PG8_STAGE(PG8_SB(0, 0), cB, voffB); PG8_STAGE(PG8_SA(0, 0), cA, voffA); PG8_STAGE(PG8_SB(0, 1), cB + hstep, voffB); PG8_STAGE(PG8_SA(0, 1), cA + hstep, voffA);
        if (wr == 1) PG8_BAR;
        PG8_WAIT_V(4); PG8_BAR;
        PG8_STAGE(PG8_SB(1, 0), cB + kstep, voffB); PG8_STAGE(PG8_SA(1, 0), cA + kstep, voffA); PG8_STAGE(PG8_SB(1, 1), cB + hstep + kstep, voffB);
        PG8_WAIT_V(6); PG8_BAR;
    }
    for (;;) {
        const bool has_next = S.next(ui + 1, nxt);
        const char* nA = has_next ? (const char*)g.A + (size_t)nxt.pm * tstep : cA; const char* nB = has_next ? (const char*)g.Bt + (size_t)nxt.pn * tstep : cB;
        for (int t = 0; t < nt; t += 2) {
            const bool last = (t == nt - 2);
            const char* a1 = cA + (size_t)(t + 1) * kstep;
            const char* a2 = last ? nA : cA + (size_t)(t + 2) * kstep; const char* b2 = last ? nB : cB + (size_t)(t + 2) * kstep;
            const char* a3 = a2 + kstep; const char* b3 = b2 + kstep;
            if (last && has_next) S.a_ready(nxt);
            if constexpr (SP2) {
            PG8_LDB(B0, 0, 0); PG8_LDB(B1, 0, 1); PG8_SCHED; PG8_LDA(At, 0, 0); PG8_STAGE(PG8_SA(1, 1), a1 + hstep, voffA);
            PG8_WAIT_V(8); PG8_WAIT_L(0); PG8_BAR; PG8_MMA(0, 0, At, B0); PG8_MMA(0, 1, At, B1); PG8_BAR; PG8_SCHED;
            PG8_LDA(At, 0, 1); PG8_STAGE(PG8_SB(0, 0), b2, voffB); PG8_STAGE(PG8_SB(0, 1), b2 + hstep, voffB); PG8_STAGE(PG8_SA(0, 0), a2, voffA);
            PG8_WAIT_V(8); PG8_WAIT_L(0); PG8_BAR; PG8_MMA(1, 0, At, B0); PG8_MMA(1, 1, At, B1); PG8_BAR; PG8_SCHED;
            PG8_LDB(B0, 1, 0); PG8_LDB(B1, 1, 1); PG8_SCHED; PG8_LDA(At, 1, 0); PG8_STAGE(PG8_SA(0, 1), a2 + hstep, voffA);
            PG8_WAIT_V(8); PG8_WAIT_L(0); PG8_BAR; PG8_MMA(0, 0, At, B0); PG8_MMA(0, 1, At, B1); PG8_BAR; PG8_SCHED;
            PG8_LDA(At, 1, 1); PG8_STAGE(PG8_SB(1, 0), b3, voffB); PG8_STAGE(PG8_SB(1, 1), b3 + hstep, voffB); PG8_STAGE(PG8_SA(1, 0), a3, voffA);
            PG8_WAIT_V(8); PG8_WAIT_L(0); PG8_BAR; PG8_MMA(1, 0, At, B0); PG8_MMA(1, 1, At, B1); PG8_BAR; PG8_SCHED;
            } else {
            PG8_LDB(B0, 0, 0); PG8_SCHED; PG8_LDA(At, 0, 0); PG8_STAGE(PG8_SA(1, 1), a1 + hstep, voffA);
            PG8_WAIT_L(8); PG8_BAR; PG8_WAIT_L(0); PG8_MMA(0, 0, At, B0); PG8_BAR; PG8_SCHED;
            PG8_LDB(B1, 0, 1); PG8_STAGE(PG8_SB(0, 0), b2, voffB);
            PG8_BAR; PG8_WAIT_L(0); PG8_MMA(0, 1, At, B1); PG8_BAR;
            PG8_LDA(At, 0, 1); PG8_STAGE(PG8_SA(0, 0), a2, voffA);
            PG8_BAR; PG8_WAIT_L(0); PG8_MMA(1, 0, At, B0); PG8_BAR; PG8_SCHED;
            PG8_STAGE(PG8_SB(0, 1), b2 + hstep, voffB);
            PG8_WAIT_V(6); PG8_BAR; PG8_MMA(1, 1, At, B1); PG8_BAR;
            PG8_LDB(B0, 1, 0); PG8_SCHED; PG8_LDA(At, 1, 0); PG8_STAGE(PG8_SA(0, 1), a2 + hstep, voffA);
            PG8_WAIT_L(8); PG8_BAR; PG8_WAIT_L(0); PG8_MMA(0, 0, At, B0); PG8_BAR; PG8_SCHED;
            PG8_LDB(B1, 1, 1); PG8_STAGE(PG8_SB(1, 0), b3, voffB);
            PG8_BAR; PG8_WAIT_L(0); PG8_MMA(0, 1, At, B1); PG8_BAR;
            PG8_LDA(At, 1, 1); PG8_STAGE(PG8_SA(1, 0), a3, voffA);
            PG8_BAR; PG8_WAIT_L(0); PG8_MMA(1, 0, At, B0); PG8_BAR; PG8_SCHED;
            PG8_STAGE(PG8_SB(1, 1), b3 + hstep, voffB);
            PG8_WAIT_V(6); PG8_BAR; PG8_MMA(1, 1, At, B1); PG8_BAR;
            }
        }
        if constexpr (ALIGN_EPI) { if (wr == 0) PG8_BAR; }
        if constexpr (!Epi::AFTER_DRAIN) { E(acc, cur, wr, wc, fr, fq); S.done(cur); }
        if (!has_next) break;
#pragma unroll
        for (int a = 0; a < 2; ++a)
#pragma unroll
            for (int b = 0; b < 2; ++b)
#pragma unroll
                for (int m = 0; m < 4; ++m)
#pragma unroll
                    for (int n = 0; n < 2; ++n) acc[a][b][m][n] = (f32x4){0.f, 0.f, 0.f, 0.f};
        cur = nxt; cA = nA; cB = nB; ++ui;
        if constexpr (ALIGN_EPI) { if (wr == 1) PG8_BAR; }
    }
    PG8_WAIT_V(0);
    if constexpr (!ALIGN_EPI) { if (wr == 0) PG8_BAR; }
    PG8_BAR;
    if constexpr (Epi::AFTER_DRAIN) { E.fused(acc, cur, wr, wc, fr, fq, lds, wid, lane); S.done(cur); }
#undef PG8_SA
#undef PG8_SB
#undef PG8_STAGE
#undef PG8_LDA
#undef PG8_LDB
#undef PG8_MMA
#undef PG8_WAIT_V
#undef PG8_WAIT_L
#undef PG8_BAR
#undef PG8_SCHED
}
}
namespace cg = cooperative_groups;
#define GAS __attribute__((address_space(1)))
#define LAS __attribute__((address_space(3)))
typedef unsigned short bf16;
typedef unsigned v4u __attribute__((ext_vector_type(4)));
typedef unsigned v2u __attribute__((ext_vector_type(2)));
typedef float f32x4 __attribute__((ext_vector_type(4)));
typedef short bf16x8 __attribute__((ext_vector_type(8)));
typedef short s16x4 __attribute__((ext_vector_type(4)));

constexpr int NWAVES = 8;
constexpr int BATCH = 2, SEQ = 8192, D = 1024, M = BATCH * SEQ;
constexpr int WA = 512, WB = 768, WBO = 256, W_IN = 5888, DFF = 2816, NG = 2048;
constexpr int LDS_BYTES = 147456;
constexpr float LOG2E = 1.4426950408889634f, LN2 = 0.6931471805599453f;

constexpr size_t MiB = 1u << 20;
constexpr size_t WS_MOD = 1 * MiB;
constexpr size_t WS_ROPE = 1 * MiB + 256 * 1024;
constexpr size_t WS_WIN = 2 * MiB;
constexpr size_t WS_WPA = 15 * MiB, WS_WPB = 16 * MiB, WS_WO = 17 * MiB, WS_WF1 = 19 * MiB, WS_WF2 = 31 * MiB;
constexpr size_t WS_H = 38 * MiB;
constexpr size_t WS_QA = 70 * MiB, WS_KA = 86 * MiB, WS_VA = 102 * MiB, WS_QB = 118 * MiB, WS_KB = 142 * MiB, WS_VB = 166 * MiB, WS_G = 190 * MiB;
constexpr size_t WS_MERGED = 86 * MiB;
constexpr size_t WS_TMP = 118 * MiB;
constexpr size_t WS_ACT = 118 * MiB;
constexpr size_t WS_END = 254 * MiB;
static_assert(WS_WIN + (size_t)W_IN * D * 2 <= WS_WPA && WS_WF1 + (size_t)2 * DFF * D * 2 <= WS_WF2 && WS_WF2 + (size_t)D * DFF * 2 <= WS_H, "weights map");
static_assert(WS_G + (size_t)M * NG * 2 <= WS_END && WS_ACT + (size_t)M * DFF * 2 <= WS_END && WS_TMP + (size_t)M * D * 4 <= WS_G, "activation map");

#define LDS_WAIT() asm volatile("s_waitcnt lgkmcnt(0)" ::: "memory")
__device__ __forceinline__ unsigned f2bf(float f) { unsigned u = __builtin_bit_cast(unsigned, f); return (u + 0x7fffu + ((u >> 16) & 1u)) >> 16; }
__device__ __forceinline__ unsigned pk2(float lo, float hi) { return f2bf(lo) | (f2bf(hi) << 16); }
__device__ __forceinline__ float wave_sum(float v) {
#pragma unroll
    for (int o = 1; o < 64; o <<= 1) v += __shfl_xor(v, o);
    return v;
}

typedef GAS unsigned gu32;
#define XB_TMO      128
#define XB_XCNT(j)  (256  + 64 * (j))
#define XB_XSUB(j)  (1280 + 64 * (j))
#define XB_XGEN(j)  (2304 + 64 * (j))
#define XB_TOP      3328
#define XB_TOPGEN   3392
#define XCD_BAR_WORDS 3456
#define XB_SPIN_CAP (1u << 18)

__device__ __forceinline__ unsigned xb_ld(unsigned* p)              { return __hip_atomic_load(p, __ATOMIC_RELAXED, __HIP_MEMORY_SCOPE_AGENT); }
__device__ __forceinline__ unsigned xb_add(unsigned* p, unsigned v) { return __hip_atomic_fetch_add(p, v, __ATOMIC_RELAXED, __HIP_MEMORY_SCOPE_AGENT); }
__device__ __forceinline__ unsigned xb_xcc_id() { return (unsigned)__builtin_amdgcn_s_getreg((3 << 11) | 20) & 0xFu; }
#define XB_SPIN(cond, bar) do { unsigned _sp = 0; while (cond) { __builtin_amdgcn_s_sleep(1); \
    if ((++_sp & 255u) == 0u) { if (xb_ld(&(bar)[XB_TMO])) break; if (_sp > XB_SPIN_CAP) { atomicAdd(&(bar)[XB_TMO], 1u); break; } } } } while (0)

struct XcdBarrier {
    unsigned* bar; unsigned x;
    volatile LAS unsigned* st;
};

__device__ __forceinline__ XcdBarrier xcd_barrier_post(unsigned* bar, volatile LAS unsigned* st) {
    XcdBarrier b; b.bar = bar; b.x = xb_xcc_id(); b.st = st;
    if (threadIdx.x == 0) (void)xb_add(&bar[XB_XCNT(b.x)], 1u);
    return b;
}
__device__ __forceinline__ void xcd_barrier_complete(unsigned* bar, unsigned x, unsigned& nloc, unsigned& nx) {
    const unsigned G = gridDim.x * gridDim.y * gridDim.z;
    unsigned sum, cnt, mine, sp = 0u;
    for (;;) {
        sum = 0u; cnt = 0u; mine = 0u;
#pragma unroll
        for (unsigned j = 0; j < 16; ++j) { const unsigned c = xb_ld(&bar[XB_XCNT(j)]); sum += c; cnt += (c > 0u) ? 1u : 0u; mine = (j == x) ? c : mine; }
        if (sum == G) break;
        __builtin_amdgcn_s_sleep(1);
        if ((++sp & 255u) == 0u) { if (xb_ld(&bar[XB_TMO])) break; if (sp > XB_SPIN_CAP) { atomicAdd(&bar[XB_TMO], 1u); break; } }
    }
    nloc = mine > 0u ? mine : 1u; nx = cnt > 0u ? cnt : 1u;
}

__device__ __forceinline__ void xcd_barrier(const XcdBarrier& b) {
    asm volatile("s_waitcnt vmcnt(0)" ::: "memory");
    __syncthreads();
    if (threadIdx.x == 0) {
        unsigned* bar = b.bar;
        __builtin_amdgcn_s_waitcnt(0);
        unsigned nloc = b.st[0], nx = b.st[1];
        if (nloc == 0u) { xcd_barrier_complete(bar, b.x, nloc, nx); b.st[0] = nloc; b.st[1] = nx; }
        const unsigned old = xb_add(&bar[XB_XSUB(b.x)], 1u);
        const unsigned gen = old / nloc;
        if (old + 1u == (gen + 1u) * nloc) {
            __builtin_amdgcn_fence(__ATOMIC_RELEASE, "agent");
            asm volatile("s_waitcnt vmcnt(0)" ::: "memory");
            const unsigned og = xb_add(&bar[XB_TOP], 1u);
            const unsigned tg = og / nx;
            if (og + 1u == (tg + 1u) * nx) xb_add(&bar[XB_TOPGEN], 1u);
            else XB_SPIN(xb_ld(&bar[XB_TOPGEN]) == tg, bar);
            __builtin_amdgcn_fence(__ATOMIC_ACQUIRE, "agent");
            xb_add(&bar[XB_XGEN(b.x)], 1u);
            asm volatile("s_waitcnt vmcnt(0)" ::: "memory");
        } else {
            XB_SPIN(xb_ld(&bar[XB_XGEN(b.x)]) == gen, bar);
            __builtin_amdgcn_fence(__ATOMIC_ACQUIRE, "agent");
            asm volatile("s_waitcnt vmcnt(0)" ::: "memory");
        }
    }
    __syncthreads();
}

struct Args { const float* in[18]; float* out; unsigned char* ws; };

__device__ __forceinline__ void transpose_item(const float* W, int ldw, int K, bf16* WT, int src_n0, int dst_row0, int k0, LAS float* scr, int lane) {
#pragma unroll
    for (int i = 0; i < 32; ++i) { const int kk = 2 * i + (lane >> 5); scr[kk * 33 + (lane & 31)] = W[(size_t)(k0 + kk) * ldw + src_n0 + (lane & 31)]; }
    LDS_WAIT(); asm volatile("" ::: "memory");
    const int c = lane & 7;
#pragma unroll
    for (int j = 0; j < 4; ++j) { const int n = (lane >> 3) + 8 * j; const LAS float* s = scr + (8 * c) * 33 + n;
        v4u o; o.x = pk2(s[0 * 33], s[1 * 33]); o.y = pk2(s[2 * 33], s[3 * 33]); o.z = pk2(s[4 * 33], s[5 * 33]); o.w = pk2(s[6 * 33], s[7 * 33]);
        *(v4u*)(WT + (size_t)(dst_row0 + n) * K + k0 + 8 * c) = o; }
    LDS_WAIT(); asm volatile("" ::: "memory");
}

__device__ __forceinline__ void norm_rows(const float* X, bf16* Y, const float* g, const float* mod_sc, const float* mod_sh, int gw, int NGW, int lane) {
    f32x4 nx[4], a[4], h[4]; int cb = -1;
    if (gw < M) {
#pragma unroll
        for (int j = 0; j < 4; ++j) nx[j] = *((const f32x4*)(X + (size_t)gw * D) + lane + 64 * j);
    }
    for (int m = gw; m < M; m += NGW) {
        f32x4 v[4]; float s = 0.f;
#pragma unroll
        for (int j = 0; j < 4; ++j) v[j] = nx[j];
        if (m + NGW < M) {
#pragma unroll
            for (int j = 0; j < 4; ++j) nx[j] = *((const f32x4*)(X + (size_t)(m + NGW) * D) + lane + 64 * j);
        }
        const int b = m >> 13;
        if (b != cb) { cb = b;
#pragma unroll
            for (int j = 0; j < 4; ++j) { const int c = lane + 64 * j; a[j] = *((const f32x4*)g + c) * (*((const f32x4*)(mod_sc + (size_t)b * 6144) + c) + 1.0f); h[j] = *((const f32x4*)(mod_sh + (size_t)b * 6144) + c); }
        }
#pragma unroll
        for (int j = 0; j < 4; ++j) s += (v[j].x * v[j].x + v[j].y * v[j].y) + (v[j].z * v[j].z + v[j].w * v[j].w);
        const float rstd = __builtin_amdgcn_rsqf(wave_sum(s) * (1.f / D) + 1e-6f);
#pragma unroll
        for (int j = 0; j < 4; ++j) { const f32x4 y = v[j] * rstd * a[j] + h[j];
            v2u o; o.x = pk2(y.x, y.y); o.y = pk2(y.z, y.w); *((v2u*)(Y + (size_t)m * D) + lane + 64 * j) = o; }
    }
}

constexpr int VRS = 160;
__device__ __forceinline__ s16x4 tr_read(const LAS unsigned char* p) { return __builtin_bit_cast(s16x4, __builtin_amdgcn_ds_read_tr16_b64_v4i16((LAS s16x4*)p)); }
__device__ __forceinline__ bf16x8 pack_p(const f32x4 a, const f32x4 b) {
    v4u w; w.x = pg8::cvt_pk_bf16(a[0], a[1]); w.y = pg8::cvt_pk_bf16(a[2], a[3]); w.z = pg8::cvt_pk_bf16(b[0], b[1]); w.w = pg8::cvt_pk_bf16(b[2], b[3]); return __builtin_bit_cast(bf16x8, w);
}
#define MFMA16(a, b, c) __builtin_amdgcn_mfma_f32_16x16x32_bf16((a), (b), (c), 0, 0, 0)

__device__ __forceinline__ void pv_step(f32x4 (&O)[4], const LAS unsigned char* vl, const bf16x8 pf, int lane) {
    const int quad = lane >> 4, qq = (lane & 15) >> 2, p = lane & 3;
    const LAS unsigned char* b0 = vl + (4 * quad + qq) * VRS + p * 8;
#pragma unroll
    for (int c = 0; c < 4; ++c) {
        const s16x4 lo = tr_read(b0 + c * 32), hi = tr_read(b0 + 16 * VRS + c * 32);
        const bf16x8 vf = (bf16x8){lo[0], lo[1], lo[2], lo[3], hi[0], hi[1], hi[2], hi[3]};
        O[c] = MFMA16(vf, pf, O[c]);
    }
}

__device__ __forceinline__ void na_task(int tk, bf16* QA, const bf16* KA, const bf16* VA, const LAS float* rpbs, LAS unsigned char* vl, int lane) {
    const int qg = tk & 3, h = (tk >> 2) & 7, r = (tk >> 5) & 127, b = tk >> 12;
    const int q = lane & 15, quad = lane >> 4;
    const int wg0 = (qg == 0) ? 0 : (qg == 1) ? 8 : (qg == 2) ? 24 : 32;
    const int rs = min(max(r - 4, 0), 120);
    const size_t tq = (size_t)b * SEQ + r * 64 + 16 * qg + q;
    bf16* qptr = QA + tq * WA + h * 64;
    const bf16x8 qf0 = *(const bf16x8*)(qptr + 8 * quad), qf1 = *(const bf16x8*)(qptr + 32 + 8 * quad);
    const bf16* kbase = KA + ((size_t)b * SEQ + rs * 64 + wg0 + q) * WA + h * 64 + 8 * quad;
    const bf16* vbase = VA + ((size_t)b * SEQ + rs * 64 + wg0 + (lane >> 3)) * WA + h * 64 + (lane & 7) * 8;
    LAS unsigned char* vw = vl + (lane >> 3) * VRS + (lane & 7) * 16;
    v4u vr[4];
#pragma unroll
    for (int i = 0; i < 4; ++i) vr[i] = *(const v4u*)(vbase + (size_t)(8 * i) * WA);
    f32x4 S[16];
#pragma unroll
    for (int i = 0; i < 16; ++i) {
        const bf16* kp = kbase + (size_t)((i >> 1) * 64 + (i & 1) * 16) * WA;
        const bf16x8 k0 = *(const bf16x8*)kp, k1 = *(const bf16x8*)(kp + 32);
        f32x4 s = MFMA16(k0, qf0, ((f32x4){0.f, 0.f, 0.f, 0.f})); S[i] = MFMA16(k1, qf1, s);
    }
    const int qc = 16 * qg + q, cs = min(max(qc - 8, 0), 48);
    const LAS float* bp = rpbs + (h * 15 + (rs - r + 7)) * 31 + (wg0 + 4 * quad - qc + 15);
    float mx = -3.0e38f;
#pragma unroll
    for (int i = 0; i < 16; ++i)
#pragma unroll
        for (int e = 0; e < 4; ++e) {
            const int kc = wg0 + 16 * (i & 1) + 4 * quad + e;
            const float bv = bp[(i >> 1) * 31 + 16 * (i & 1) + e];
            float t = (S[i][e] + bv) * LOG2E;
            t = ((unsigned)(kc - cs) < 16u) ? t : -1.0e30f;
            S[i][e] = t; mx = fmaxf(mx, t);
        }
    mx = fmaxf(mx, __shfl_xor(mx, 16)); mx = fmaxf(mx, __shfl_xor(mx, 32));
    float l = 0.f;
#pragma unroll
    for (int i = 0; i < 16; ++i)
#pragma unroll
        for (int e = 0; e < 4; ++e) { const float p = __builtin_amdgcn_exp2f(S[i][e] - mx); S[i][e] = p; l += p; }
    l += __shfl_xor(l, 16); l += __shfl_xor(l, 32);
    f32x4 O[4];
#pragma unroll
    for (int c = 0; c < 4; ++c) O[c] = (f32x4){0.f, 0.f, 0.f, 0.f};
#pragma unroll
    for (int ks = 0; ks < 8; ++ks) {
#pragma unroll
        for (int i = 0; i < 4; ++i) *(LAS v4u*)(vw + 8 * i * VRS) = vr[i];
        if (ks < 7) {
#pragma unroll
            for (int i = 0; i < 4; ++i) vr[i] = *(const v4u*)(vbase + (size_t)((ks + 1) * 64 + 8 * i) * WA);
        }
        pv_step(O, vl, pack_p(S[2 * ks], S[2 * ks + 1]), lane);
    }
    const float rl = __builtin_amdgcn_rcpf(l);
#pragma unroll
    for (int c = 0; c < 4; ++c) { const f32x4 o = O[c] * rl; v2u w; w.x = pg8::cvt_pk_bf16(o[0], o[1]); w.y = pg8::cvt_pk_bf16(o[2], o[3]); *(v2u*)(qptr + 16 * c + 4 * quad) = w; }
}

__device__ __forceinline__ void dil_task(int g, int idx, bf16* QB, const bf16* KB, const bf16* VB, float* LSE, LAS unsigned char* vl, int lane) {
    const int sh = 2 * g, dil = 1 << sh, seg = SEQ >> sh, nblk = seg >> 4;
    const int jb = idx & (nblk - 1); int rest = idx >> (9 - sh); const int res = rest & (dil - 1); rest >>= sh; const int hg = rest & 3, b = rest >> 2, head = 4 * g + hg;
    const int q = lane & 15, quad = lane >> 4;
    const int lq = 16 * jb + q;
    const size_t tq = (size_t)b * SEQ + (size_t)lq * dil + res;
    bf16* qptr = QB + tq * WB + head * 64;
    const bf16x8 qf0 = *(const bf16x8*)(qptr + 8 * quad), qf1 = *(const bf16x8*)(qptr + 32 + 8 * quad);
    const int l0 = 16 * jb - 64;
    const bf16* kb0 = KB + ((size_t)b * SEQ + res) * WB + head * 64 + 8 * quad;
    const bf16* vb0 = VB + ((size_t)b * SEQ + res) * WB + head * 64 + (lane & 7) * 8;
    LAS unsigned char* vw = vl + (lane >> 3) * VRS + (lane & 7) * 16;
    v4u vr[4];
#pragma unroll
    for (int i = 0; i < 4; ++i) { const int lk = min(max(l0 + (lane >> 3) + 8 * i, 0), seg - 1); vr[i] = *(const v4u*)(vb0 + (size_t)lk * dil * WB); }
    f32x4 S[10];
#pragma unroll
    for (int i = 0; i < 9; ++i) {
        const int lk = min(max(l0 + 16 * i + q, 0), seg - 1);
        const bf16* kp = kb0 + (size_t)lk * dil * WB;
        const bf16x8 k0 = *(const bf16x8*)kp, k1 = *(const bf16x8*)(kp + 32);
        f32x4 s = MFMA16(k0, qf0, ((f32x4){0.f, 0.f, 0.f, 0.f})); S[i] = MFMA16(k1, qf1, s);
    }
    S[9] = (f32x4){0.f, 0.f, 0.f, 0.f};
    float mx = -3.0e38f;
#pragma unroll
    for (int i = 0; i < 9; ++i)
#pragma unroll
        for (int e = 0; e < 4; ++e) {
            const int lk = l0 + 16 * i + 4 * quad + e, dd = lk - lq;
            const bool valid = (lk >= 0) && (lk < seg) && (dd <= 64) && (dd >= -64);
            const float t = valid ? S[i][e] * LOG2E : -1.0e30f;
            S[i][e] = t; mx = fmaxf(mx, t);
        }
    mx = fmaxf(mx, __shfl_xor(mx, 16)); mx = fmaxf(mx, __shfl_xor(mx, 32));
    float l = 0.f;
#pragma unroll
    for (int i = 0; i < 9; ++i)
#pragma unroll
        for (int e = 0; e < 4; ++e) { const float p = __builtin_amdgcn_exp2f(S[i][e] - mx); S[i][e] = p; l += p; }
    l += __shfl_xor(l, 16); l += __shfl_xor(l, 32);
    f32x4 O[4];
#pragma unroll
    for (int c = 0; c < 4; ++c) O[c] = (f32x4){0.f, 0.f, 0.f, 0.f};
#pragma unroll
    for (int ks = 0; ks < 5; ++ks) {
#pragma unroll
        for (int i = 0; i < 4; ++i) *(LAS v4u*)(vw + 8 * i * VRS) = vr[i];
        if (ks < 4) {
#pragma unroll
            for (int i = 0; i < 4; ++i) { const int lk = min(max(l0 + 32 * (ks + 1) + (lane >> 3) + 8 * i, 0), seg - 1); vr[i] = *(const v4u*)(vb0 + (size_t)lk * dil * WB); }
        }
        pv_step(O, vl, pack_p(S[2 * ks], S[2 * ks + 1]), lane);
    }
    const float rl = __builtin_amdgcn_rcpf(l);
#pragma unroll
    for (int c = 0; c < 4; ++c) { const f32x4 o = O[c] * rl; v2u w; w.x = pg8::cvt_pk_bf16(o[0], o[1]); w.y = pg8::cvt_pk_bf16(o[2], o[3]); *(v2u*)(qptr + 16 * c + 4 * quad) = w; }
    if (quad == 0) LSE[tq * 12 + head] = (mx + __builtin_amdgcn_logf(l)) * LN2;
}

__global__ void __launch_bounds__(NWAVES * 64, 2) enc_fwd(Args args) {
    extern __shared__ __attribute__((aligned(16))) unsigned char lds_raw[];
    cg::grid_group grid = cg::this_grid();
    LAS unsigned char* lds = (LAS unsigned char*)lds_raw;
    const int tid = threadIdx.x, lane = tid & 63, wave = __builtin_amdgcn_readfirstlane(tid >> 6);
    const int G = gridDim.x, bx = blockIdx.x;
    const int vcu = (G % 8 == 0) ? (bx % 8) * (G / 8) + bx / 8 : bx;
    const int gw = vcu * NWAVES + wave, NGW = G * NWAVES;
    unsigned char* ws = args.ws;
    const float *x = args.in[0], *c = args.in[1], *w_ada = args.in[2], *b_ada = args.in[3], *g_norm1 = args.in[4], *g_norm2 = args.in[5], *w_in = args.in[6], *b_gate = args.in[7];
    const float *g_qa = args.in[8], *g_ka = args.in[9], *g_qb = args.in[10], *g_kb = args.in[11], *rpb = args.in[12], *w_pa = args.in[13], *w_pb = args.in[14], *w_o = args.in[15], *w_f1 = args.in[16], *w_f2 = args.in[17];
    float* out = args.out;
    unsigned* BARW = (unsigned*)(ws + 64 * 1024);
    volatile LAS unsigned* BST = (volatile LAS unsigned*)(lds + LDS_BYTES - 64);
    if (bx == 0) { for (int i = tid; i < XCD_BAR_WORDS; i += NWAVES * 64) __hip_atomic_store(BARW + i, 0u, __ATOMIC_RELAXED, __HIP_MEMORY_SCOPE_AGENT); }
    if (tid == 0) { BST[0] = 0u; BST[1] = 0u; }
    float* MOD = (float*)(ws + WS_MOD); float* ROPE = (float*)(ws + WS_ROPE);
    bf16 *WIN = (bf16*)(ws + WS_WIN), *WPA = (bf16*)(ws + WS_WPA), *WPB = (bf16*)(ws + WS_WPB), *WO = (bf16*)(ws + WS_WO), *WF1 = (bf16*)(ws + WS_WF1), *WF2 = (bf16*)(ws + WS_WF2);
    bf16 *H = (bf16*)(ws + WS_H), *QA = (bf16*)(ws + WS_QA), *KA = (bf16*)(ws + WS_KA), *VA = (bf16*)(ws + WS_VA), *QB = (bf16*)(ws + WS_QB), *KB = (bf16*)(ws + WS_KB), *VB = (bf16*)(ws + WS_VB), *GT = (bf16*)(ws + WS_G);
    float* LSE = (float*)(ws + WS_H); bf16* OB = (bf16*)(ws + WS_H + 1 * MiB);
    bf16* MERGED = (bf16*)(ws + WS_MERGED); float* TMP = (float*)(ws + WS_TMP); bf16* ACT = (bf16*)(ws + WS_ACT);

#if defined(PROBE_A)
    float* EPS = (float*)(ws + 512 * 1024); volatile unsigned long long* TPREV = (volatile unsigned long long*)(ws + 512 * 1024 + 64); volatile float* TA = (volatile float*)(ws + 512 * 1024 + 128);
    if (bx == 0 && tid == 0) { *TPREV = __builtin_amdgcn_s_memrealtime(); *TA = 0.f; }
#define STAMP(k) do { if (bx == 0 && tid == 0) { const unsigned long long t_ = __builtin_amdgcn_s_memrealtime(); const float d_ = (float)(t_ - *TPREV) * 0.01f; \
        if ((k) == PROBE_A) *TA = d_; if ((k) == PROBE_B) __hip_atomic_store(EPS, d_ * 1e-4f, __ATOMIC_RELAXED, __HIP_MEMORY_SCOPE_AGENT); *TPREV = t_; } } while (0)
#else
#define STAMP(k) do { } while (0)
#endif
    {
        LAS float* scr = (LAS float*)(lds + wave * 16384);
        constexpr int I_IN = 16 * (W_IN / 32), I_PA = 8 * 32, I_PB = 4 * 32, I_O = 16 * 32, I_F1 = 16 * (2 * DFF / 32), I_F2 = (DFF / 64) * 32;
        constexpr int NITEMS = I_IN + I_PA + I_PB + I_O + I_F1 + I_F2;
        for (int it = gw; it < NITEMS; it += NGW) {
            int r = it;
            if (r < I_IN) { const int nb = r % (W_IN / 32), kb = r / (W_IN / 32), pn = nb >> 3, g8 = nb & 7, bj = g8 >> 2, wc = g8 & 3;
                transpose_item(w_in, W_IN, D, WIN, 256 * pn + 64 * wc + 32 * bj, 32 * nb, 64 * kb, scr, lane); continue; } r -= I_IN;
            if (r < I_PA) { transpose_item(w_pa, D, WA, WPA, 32 * (r % 32), 32 * (r % 32), 64 * (r / 32), scr, lane); continue; } r -= I_PA;
            if (r < I_PB) { transpose_item(w_pb, D, WBO, WPB, 32 * (r % 32), 32 * (r % 32), 64 * (r / 32), scr, lane); continue; } r -= I_PB;
            if (r < I_O) { transpose_item(w_o, D, D, WO, 32 * (r % 32), 32 * (r % 32), 64 * (r / 32), scr, lane); continue; } r -= I_O;
            if (r < I_F1) { const int nb = r % (2 * DFF / 32), kb = r / (2 * DFF / 32), pn = nb >> 3, g8 = nb & 7, bj = g8 >> 2, j32 = g8 & 3;
                transpose_item(w_f1, 2 * DFF, D, WF1, bj * DFF + 128 * pn + 32 * j32, 32 * nb, 64 * kb, scr, lane); continue; } r -= I_F1;
            transpose_item(w_f2, D, DFF, WF2, 32 * (r % 32), 32 * (r % 32), 64 * (r / 32), scr, lane);
        }
        for (int e = bx * 512 + tid; e < SEQ * 8; e += G * 512) {
            const int pos = e >> 3, i = e & 7;
            const double ir = (i == 0) ? 0.15915494309189535 : (i == 1) ? 0.03086376340470123 : (i == 2) ? 0.005985185712713705 : (i == 3) ? 0.001160663641240061 :
                              (i == 4) ? 0.00022507907903927653 : (i == 5) ? 4.364795279280289e-05 : (i == 6) ? 8.464330808241401e-06 : 1.6414262627950345e-06;
            const double rev = (double)pos * ir; const float fr = (float)(rev - __builtin_floor(rev));
            ROPE[pos * 16 + i] = __builtin_amdgcn_cosf(fr); ROPE[pos * 16 + 8 + i] = __builtin_amdgcn_sinf(fr);
        }
        __syncthreads();
        if (bx < 96) {
            LAS float* sc_l = (LAS float*)(lds + 8192);
            for (int i = tid; i < 2 * D; i += NWAVES * 64) { const float cv = c[i]; sc_l[i] = cv * __builtin_amdgcn_rcpf(1.0f + __expf(-cv)); }
            __syncthreads();
            const int n = 64 * bx + lane; float a0 = 0.f, a1 = 0.f;
#pragma unroll 4
            for (int k0 = 128 * wave; k0 < 128 * wave + 128; k0 += 32) {
                float wv[32];
#pragma unroll
                for (int k = 0; k < 32; ++k) wv[k] = w_ada[(size_t)(k0 + k) * 6144 + n];
#pragma unroll
                for (int k = 0; k < 32; ++k) { a0 += sc_l[k0 + k] * wv[k]; a1 += sc_l[D + k0 + k] * wv[k]; }
            }
            LAS float* red = (LAS float*)lds;
            red[(wave * 2 + 0) * 64 + lane] = a0; red[(wave * 2 + 1) * 64 + lane] = a1;
            __syncthreads();
            if (wave < 2) { float s = b_ada[n];
#pragma unroll
                for (int w = 0; w < 8; ++w) s += red[(w * 2 + wave) * 64 + lane];
                MOD[wave * 6144 + n] = s; }
        }
    }
    grid.sync(); STAMP(0);
    const XcdBarrier xbar = xcd_barrier_post(BARW, BST);
    { int ln = lane; asm volatile("" : "+v"(ln)); norm_rows(x, H, g_norm1, MOD + 1024, MOD, gw, NGW, ln); }
    xcd_barrier(xbar); STAMP(1);
    {
        pg8::Gemm g{H, WIN, M, W_IN, D}; pg8::StaticOrder S; S.init(M, W_IN, G, bx);
        pg8::EpiIn E{QA, KA, VA, QB, KB, VB, GT, g_qa, g_ka, g_qb, g_kb, b_gate, ROPE};
        pg8::gemm_phase<pg8::EpiIn, pg8::StaticOrder, true, true>(lds, g, S, E);
    }
    xcd_barrier(xbar); STAMP(2);
    {
        LAS float* rpbs = (LAS float*)lds;
        for (int i = tid; i < 3720; i += 512) rpbs[64 + i] = rpb[i];
        __syncthreads();
        LAS unsigned char* vl = lds + 16384 + wave * 5120;
        int lane_ = lane; asm volatile("" : "+v"(lane_));
        for (int tk = gw; tk < 8192; tk += NGW) na_task(tk, QA, KA, VA, rpbs + 64, vl, lane_);
#if defined(PROBE_A)
        xcd_barrier(xbar); STAMP(3);
#endif
        for (int tk = gw; tk < 12288; tk += NGW) dil_task(tk >> 12, tk & 4095, QB, KB, VB, LSE, vl, lane_);
    }
    xcd_barrier(xbar); STAMP(4);
    int tid3 = tid; asm volatile("" : "+v"(tid3));
    for (int e = bx * 512 + tid3; e < M * 32; e += G * 512) {
        const int tok = e >> 5, hg = (e >> 3) & 3, ch = e & 7;
        const float l0 = LSE[(size_t)tok * 12 + hg], l1 = LSE[(size_t)tok * 12 + 4 + hg], l2 = LSE[(size_t)tok * 12 + 8 + hg];
        const float mxl = fmaxf(l0, fmaxf(l1, l2)); float w0 = __expf(l0 - mxl), w1 = __expf(l1 - mxl), w2 = __expf(l2 - mxl); const float rs = 1.0f / (w0 + w1 + w2); w0 *= rs; w1 *= rs; w2 *= rs;
        const bf16* op = QB + (size_t)tok * WB + hg * 64 + ch * 8;
        const v4u a = *(const v4u*)op, b = *(const v4u*)(op + 256), cc = *(const v4u*)(op + 512);
        v4u o;
#define MRG(f) pk2(w0 * pg8::bf_lo(a.f) + w1 * pg8::bf_lo(b.f) + w2 * pg8::bf_lo(cc.f), w0 * pg8::bf_hi(a.f) + w1 * pg8::bf_hi(b.f) + w2 * pg8::bf_hi(cc.f))
        o.x = MRG(x); o.y = MRG(y); o.z = MRG(z); o.w = MRG(w);
#undef MRG
        *(v4u*)(OB + (size_t)tok * WBO + hg * 64 + ch * 8) = o;
    }
    xcd_barrier(xbar); STAMP(5);
    {
        pg8::StaticOrder S; S.init(M, D, G, bx);
        { pg8::Gemm g{QA, WPA, M, D, WA}; pg8::EpiGateA E{GT, NG, TMP}; pg8::gemm_phase<pg8::EpiGateA, pg8::StaticOrder, true, true>(lds, g, S, E); }
        { pg8::Gemm g{OB, WPB, M, D, WBO}; pg8::EpiGateB E{GT + 1024, NG, TMP, MERGED}; pg8::gemm_phase<pg8::EpiGateB, pg8::StaticOrder, true, true>(lds, g, S, E); }
    }
    xcd_barrier(xbar); STAMP(6);
    {
        pg8::Gemm g{MERGED, WO, M, D, D}; pg8::StaticOrder S; S.init(M, D, G, bx);
        pg8::EpiRes E{x, out, MOD + 2048, 1.0f}; pg8::gemm_phase<pg8::EpiRes, pg8::StaticOrder, true, true>(lds, g, S, E);
    }
    xcd_barrier(xbar); STAMP(7);
    { int ln = lane; asm volatile("" : "+v"(ln)); norm_rows(out, H, g_norm2, MOD + 4096, MOD + 3072, gw, NGW, ln); }
    xcd_barrier(xbar); STAMP(8);
#if defined(PROBE_A)
    xcd_barrier(xbar); STAMP(9);
#endif
    {
        pg8::Gemm g{H, WF1, M, 2 * DFF, D}; pg8::StaticOrder S; S.init(M, 2 * DFF, G, bx);
        pg8::EpiSwiglu E{ACT, DFF}; pg8::gemm_phase<pg8::EpiSwiglu, pg8::StaticOrder, true, true>(lds, g, S, E);
    }
    xcd_barrier(xbar); STAMP(10);
    {
        pg8::Gemm g{ACT, WF2, M, D, DFF}; pg8::StaticOrder S; S.init(M, D, G, bx);
#if defined(PROBE_A)
        const float osc = 1.0f + __hip_atomic_load(EPS, __ATOMIC_RELAXED, __HIP_MEMORY_SCOPE_AGENT);
#else
        const float osc = 1.0f;
#endif
        pg8::EpiRes E{out, out, MOD + 5120, osc}; pg8::gemm_phase<pg8::EpiRes, pg8::StaticOrder, true, true>(lds, g, S, E);
    }
#if defined(PROBE_A)
    xcd_barrier(xbar); STAMP(11);
    if (bx == 0 && tid == 0) out[0] += *TA * 0.1f;
#endif
}

extern "C" void kernel_launch(void* const* d_in, const int* in_sizes, int n_in, void* d_out, int out_size, void* d_ws, size_t ws_size, hipStream_t stream) {
    static int grid = 0;
    if (grid == 0) {
        if (n_in != 18 || in_sizes[0] != M * D || out_size != M * D || ws_size < WS_END) { fprintf(stderr, "kernel_launch: unexpected shapes (n_in %d, in0 %d, out %d, ws %zu); nothing launched\n", n_in, n_in > 0 ? in_sizes[0] : -1, out_size, ws_size); grid = -1; return; }
        int dev = 0, cus = 0, per_cu = 0;
        if (hipGetDevice(&dev) != hipSuccess || hipDeviceGetAttribute(&cus, hipDeviceAttributeMultiprocessorCount, dev) != hipSuccess) { grid = -1; return; }
        if (hipFuncSetAttribute((const void*)enc_fwd, hipFuncAttributeMaxDynamicSharedMemorySize, LDS_BYTES) != hipSuccess) { fprintf(stderr, "kernel_launch: hipFuncSetAttribute failed\n"); grid = -1; return; }
        if (hipOccupancyMaxActiveBlocksPerMultiprocessor(&per_cu, (const void*)enc_fwd, NWAVES * 64, LDS_BYTES) != hipSuccess || per_cu < 1) { fprintf(stderr, "kernel_launch: occupancy query gave %d\n", per_cu); (void)hipGetLastError(); per_cu = 1; }
        grid = cus * 1;
        (void)per_cu;
    }
    if (grid < 0) return;
    Args a{};
    for (int i = 0; i < 18; ++i) a.in[i] = (const float*)d_in[i];
    a.out = (float*)d_out; a.ws = (unsigned char*)d_ws;
    void* kargs[] = {&a};
    const hipError_t le = hipLaunchCooperativeKernel((const void*)enc_fwd, dim3(grid), dim3(NWAVES * 64), kargs, LDS_BYTES, stream);
    if (le != hipSuccess) fprintf(stderr, "kernel_launch: cooperative launch failed: %s (grid %d)\n", hipGetErrorName(le), grid);
}
```
